# Optimizing an MI355X kernel written in HIP

```python
import jax, jax.numpy as jnp
from jax import lax
import numpy as np

D_MODEL = 1024
BATCH = 8
SEQ = 4096
DEPTH = 1

N_META = 16
N_HEADS = 8
HEAD_DIM = 128
D_ATTN = N_HEADS * HEAD_DIM
D_CONV = D_MODEL
CONV_WIDTH = 3
D_FF = 2816
Q_BLOCK = 128
N_BRANCH = 2
RMS_EPS = 1e-6

D_IN = 3 * D_ATTN + N_HEADS + 3 * D_CONV + N_BRANCH * D_MODEL
SPLIT_POINTS = [D_ATTN, 2 * D_ATTN, 3 * D_ATTN, 3 * D_ATTN + N_HEADS,
                3 * D_ATTN + N_HEADS + D_CONV, 3 * D_ATTN + N_HEADS + 2 * D_CONV,
                3 * D_ATTN + N_HEADS + 3 * D_CONV]

kernel_name = "hybrid_fox_shortconv_gated_merge"


def rms_norm(x, g):
    xf = x.astype(jnp.float32)
    y = xf * lax.rsqrt(jnp.mean(xf * xf, axis=-1, keepdims=True) + RMS_EPS)
    return (y * g.astype(jnp.float32)).astype(x.dtype)


def causal_dwconv(u, w):
    L = u.shape[1]
    up = jnp.pad(u, ((0, 0), (CONV_WIDTH - 1, 0), (0, 0)))
    out = up[:, 0:L] * w[0]
    for k in range(1, CONV_WIDTH):
        out = out + up[:, k:k + L] * w[k]
    return out


def forgetting_attention(q, k, v, cum_logf):
    B, L = q.shape[0], q.shape[1]
    n_real = L - N_META
    n_blk = n_real // Q_BLOCK
    scale = HEAD_DIM ** -0.5
    cum_t = jnp.transpose(cum_logf, (0, 2, 1))
    kpos = jnp.arange(L)

    def attend(args):
        q_blk, c_blk, qpos = args
        s = jnp.einsum('bqhd,bkhd->bhqk', q_blk, k,
                       preferred_element_type=jnp.float32) * scale
        s = s + (c_blk[..., :, None] - cum_t[..., None, :])
        mask = kpos[None, :] <= qpos[:, None]
        s = jnp.where(mask, s, -jnp.inf)
        p = jax.nn.softmax(s, axis=-1)
        return jnp.einsum('bhqk,bkhd->bqhd', p.astype(v.dtype), v)

    o_meta = attend((q[:, :N_META], cum_t[:, :, :N_META], jnp.arange(N_META)))
    q_r = q[:, N_META:].reshape(B, n_blk, Q_BLOCK, N_HEADS, HEAD_DIM).transpose(1, 0, 2, 3, 4)
    c_r = cum_t[:, :, N_META:].reshape(B, N_HEADS, n_blk, Q_BLOCK).transpose(2, 0, 1, 3)
    pos_r = (N_META + jnp.arange(n_real)).reshape(n_blk, Q_BLOCK)
    o_r = lax.map(attend, (q_r, c_r, pos_r))
    o_r = o_r.transpose(1, 0, 2, 3, 4).reshape(B, n_real, N_HEADS, HEAD_DIM)
    return jnp.concatenate([o_meta, o_r], axis=1)


def hybrid_mixer(h, w_in, b_f, conv_w, w_o_attn, w_o_conv, w_o):
    B, L, _ = h.shape
    proj = h @ w_in
    q, k, v, f_logit, gb, gc, u, gates = jnp.split(proj, SPLIT_POINTS, axis=-1)
    log_f = jax.nn.log_sigmoid((f_logit + b_f).astype(jnp.float32))
    cum_logf = jnp.cumsum(log_f, axis=1)
    att = forgetting_attention(q.reshape(B, L, N_HEADS, HEAD_DIM),
                               k.reshape(B, L, N_HEADS, HEAD_DIM),
                               v.reshape(B, L, N_HEADS, HEAD_DIM), cum_logf)
    y_att = att.reshape(B, L, D_ATTN) @ w_o_attn
    y_conv = (gb * causal_dwconv(gc * u, conv_w)) @ w_o_conv
    g_att, g_conv = jnp.split(jax.nn.sigmoid(gates), N_BRANCH, axis=-1)
    return (g_att * y_att + g_conv * y_conv) @ w_o


def conv_glu(h, w_ffn_in, ffn_conv_w, w_ffn_out):
    a, val = jnp.split(h @ w_ffn_in, 2, axis=-1)
    return (jax.nn.silu(causal_dwconv(a, ffn_conv_w)) * val) @ w_ffn_out


def setup_inputs(seed: int = 0) -> dict:
    key = jax.random.key(seed)
    ks = jax.random.split(key, 16)
    nrm = lambda k, shape, fan_in: jax.random.normal(k, shape, jnp.float32) * (fan_in ** -0.5)
    return {
        "x": jax.random.normal(ks[0], (BATCH, SEQ, D_MODEL), jnp.float32),
        "meta_tokens": jax.random.normal(ks[1], (N_META, D_MODEL), jnp.float32),
        "g_mix": 1.0 + 0.02 * jax.random.normal(ks[2], (DEPTH, D_MODEL), jnp.float32),
        "w_in": nrm(ks[3], (DEPTH, D_MODEL, D_IN), D_MODEL),
        "b_f": jax.random.uniform(ks[4], (DEPTH, N_HEADS), jnp.float32, 1.0, 6.0),
        "conv_w": nrm(ks[5], (DEPTH, CONV_WIDTH, D_CONV), CONV_WIDTH),
        "w_o_attn": nrm(ks[6], (DEPTH, D_ATTN, D_MODEL), D_ATTN),
        "w_o_conv": nrm(ks[7], (DEPTH, D_CONV, D_MODEL), D_CONV),
        "w_o": nrm(ks[8], (DEPTH, D_MODEL, D_MODEL), D_MODEL),
        "g_ffn": 1.0 + 0.02 * jax.random.normal(ks[9], (DEPTH, D_MODEL), jnp.float32),
        "w_ffn_in": nrm(ks[10], (DEPTH, D_MODEL, 2 * D_FF), D_MODEL),
        "ffn_conv_w": nrm(ks[11], (DEPTH, CONV_WIDTH, D_FF), CONV_WIDTH),
        "w_ffn_out": nrm(ks[12], (DEPTH, D_FF, D_MODEL), D_FF),
        "g_final": 1.0 + 0.02 * jax.random.normal(ks[13], (D_MODEL,), jnp.float32),
    }


def reference(x, meta_tokens, g_mix, w_in, b_f, conv_w, w_o_attn, w_o_conv, w_o,
              g_ffn, w_ffn_in, ffn_conv_w, w_ffn_out, g_final):
    B = x.shape[0]
    meta = jnp.broadcast_to(meta_tokens.astype(x.dtype)[None], (B, N_META, x.shape[-1]))
    z = jnp.concatenate([meta, x], axis=1)
    for l in range(DEPTH):
        z = z + hybrid_mixer(rms_norm(z, g_mix[l]), w_in[l], b_f[l], conv_w[l],
                             w_o_attn[l], w_o_conv[l], w_o[l])
        z = z + conv_glu(rms_norm(z, g_ffn[l]), w_ffn_in[l], ffn_conv_w[l], w_ffn_out[l])
    return rms_norm(z, g_final)[:, N_META:]
```

```cpp
#include <hip/hip_runtime.h>
#include <hip/hip_cooperative_groups.h>
#include <hip/hip_bf16.h>
#include <cstdio>
#include <cstdint>
#include <cmath>
namespace cg = cooperative_groups;
namespace pg8 {
#define PG8_LAS __attribute__((address_space(3)))
typedef unsigned short bf16_t;
typedef short bf16x8 __attribute__((ext_vector_type(8)));
typedef float f32x4 __attribute__((ext_vector_type(4)));
typedef unsigned u32x4 __attribute__((ext_vector_type(4)));
constexpr int BM = 256, BK = 64, HALF = 128, HTB = HALF * BK * 2  , STAGE_BYTES = 8 * HTB, NXCD = 8, WGM = 8;

__host__ __device__ __forceinline__ int lds_byte(int r, int c) { const int st = (r >> 4) * 2 + (c >> 5), rr = r & 15, cc = c & 31, ob = rr * 64 + cc * 2; return st * 1024 + (ob ^ (((ob >> 9) & 1) << 5)); }
__host__ __device__ __forceinline__ void stage_rc(int b, int& R, int& C) { const int st = b / 1024, sb = b % 1024, swz = sb ^ (((sb >> 9) & 1) << 5); R = (st >> 1) * 16 + swz / 64; C = (st & 1) * 32 + (swz % 64) / 2; }
__host__ __device__ __forceinline__ int perm32(int rho) { const int n = rho >> 4, i = rho & 15; return 8 * (i >> 2) + 4 * n + (i & 3); }

__host__ __device__ __forceinline__ int arow(int pm) { return (pm >> 4) * 4112 + 16 + (pm & 15) * 256; }
struct Unit { int pm, pn; };
struct Gemm { const bf16_t* A; const bf16_t* Bt; int M, N, K; int nt2 = 0; long dA = 0, dB = 0; };

struct StaticOrder {
    int nM, nN, nwg, G, c;
    __host__ __device__ void init(int M, int N, int G_, int c_) { nM = M / BM; nN = N / BM; nwg = nM * nN; G = G_; c = c_; }
    __host__ __device__ bool next(int i, Unit& u) const {
        const long L = (long)i * G + c; if (L >= nwg) return false;
        int wgid = (int)L; { const int q = nwg / NXCD, r = nwg % NXCD, xcd = wgid % NXCD, off = wgid / NXCD; wgid = (xcd < r ? xcd * (q + 1) : r * (q + 1) + (xcd - r) * q) + off; }
        const int nig = WGM * nN, gid = wgid / nig, fm = gid * WGM, gsz = (nM - fm) < WGM ? (nM - fm) : WGM;
        u.pm = fm + ((wgid % nig) % gsz); u.pn = (wgid % nig) / gsz; return true;
    }
    __device__ __forceinline__ void a_ready(const Unit&) const {}
    __device__ __forceinline__ void done(const Unit&) const {}
};

typedef float f32x2c_t __attribute__((ext_vector_type(2))); typedef __bf16 bf16x2c_t __attribute__((ext_vector_type(2)));
__device__ __forceinline__ unsigned cvt_pk_bf16(float lo, float hi) { f32x2c_t v = {lo, hi}; return __builtin_bit_cast(unsigned, __builtin_convertvector(v, bf16x2c_t)); }
typedef float f32x2 __attribute__((ext_vector_type(2)));
template <class Epi, class Sched, bool ALIGN_EPI = false, bool SP2 = false>
__device__ __forceinline__ void gemm_phase(PG8_LAS unsigned char* lds, const Gemm g, const Sched& S, const Epi& E) {
    const int tid = threadIdx.x, wid = __builtin_amdgcn_readfirstlane(tid >> 6), lane = tid & 63, wr = wid >> 2, wc = wid & 3, fr = lane & 15, fq = lane >> 4;
    const int K = g.K, nt1 = K / BK, nt = Epi::HAS_MID ? nt1 + g.nt2 : nt1;
    unsigned voffA[2], voffB[2];
#pragma unroll
    for (int i = 0; i < 2; ++i) { int R, C; stage_rc(tid * 16 + i * 8192, R, C); const int Rb = Epi::PERM ? ((R & ~31) + perm32(R & 31)) : R;
        voffA[i] = (unsigned)(R * K + C) * 2u; voffB[i] = (unsigned)(Rb * K + C) * 2u; }
    const size_t kstep = (size_t)(BK * 2);
    const size_t hstep = (size_t)HALF * K * 2;
    const size_t tstep = 2 * hstep;
    const unsigned ldsw = (unsigned)wid * 1024u;
    const int aoff = lds_byte(wr * 64 + fr, fq * 8), boff = lds_byte(wc * 32 + fr, fq * 8);
#define PG8_SA(b, h) (((b) * 2 + (h)) * HTB)
#define PG8_SB(b, h) ((4 + (b) * 2 + (h)) * HTB)
#define PG8_STAGE(bufoff, gbase, voff) do { _Pragma("unroll") for (int _i = 0; _i < 2; ++_i) \
        __builtin_amdgcn_global_load_lds((const unsigned*)((const char*)(gbase) + (voff)[_i]), (PG8_LAS unsigned*)(lds + (bufoff) + ldsw + _i * 8192), 16, 0, 0); } while (0)
#define PG8_LDA(dst, b, h) do { _Pragma("unroll") for (int m = 0; m < 4; ++m) _Pragma("unroll") for (int k = 0; k < 2; ++k) dst[m][k] = *(const PG8_LAS bf16x8*)(lds + PG8_SA(b, h) + aoff + m * 2048 + k * 1024); } while (0)
#define PG8_LDB(dst, b, h) do { _Pragma("unroll") for (int n = 0; n < 2; ++n) _Pragma("unroll") for (int k = 0; k < 2; ++k) dst[n][k] = *(const PG8_LAS bf16x8*)(lds + PG8_SB(b, h) + boff + n * 2048 + k * 1024); } while (0)
#define PG8_MMA(ai, bj, At, Bt) do { __builtin_amdgcn_s_setprio(1); _Pragma("unroll") for (int m = 0; m < 4; ++m) _Pragma("unroll") for (int n = 0; n < 2; ++n) _Pragma("unroll") for (int k = 0; k < 2; ++k) \
        acc[ai][bj][m][n] = __builtin_amdgcn_mfma_f32_16x16x32_bf16(Bt[n][k], At[m][k], acc[ai][bj][m][n], 0, 0, 0); __builtin_amdgcn_s_setprio(0); } while (0)
#define PG8_WAIT_V(n) asm volatile("s_waitcnt vmcnt(" #n ")" ::: "memory")
#define PG8_WAIT_L(n) asm volatile("s_waitcnt lgkmcnt(" #n ")" ::: "memory")
#define PG8_BAR __builtin_amdgcn_s_barrier()
#define PG8_SCHED __builtin_amdgcn_sched_barrier(0)
    Unit cur, nxt; int ui = 0;
    if (!S.next(0, cur)) return;
    f32x4 acc[2][2][4][2];
#pragma unroll
    for (int a = 0; a < 2; ++a)
#pragma unroll
        for (int b = 0; b < 2; ++b)
#pragma unroll
            for (int m = 0; m < 4; ++m)
#pragma unroll
                for (int n = 0; n < 2; ++n) acc[a][b][m][n] = (f32x4){0.f, 0.f, 0.f, 0.f};
    bf16x8 At[4][2], B0[2][2], B1[2][2];
    const char* cA = (const char*)g.A + (size_t)arow(cur.pm) * (size_t)K * 2; const char* cB = (const char*)g.Bt + (size_t)cur.pn * tstep;
    S.a_ready(cur);
    if constexpr (SP2) {
        PG8_STAGE(PG8_SB(0, 0), cB, voffB); PG8_STAGE(PG8_SB(0, 1), cB + hstep, voffB); PG8_STAGE(PG8_SA(0, 0), cA, voffA); PG8_STAGE(PG8_SA(0, 1), cA + hstep, voffA);
        if (wr == 1) PG8_BAR;
        PG8_WAIT_V(2); PG8_BAR;
        PG8_STAGE(PG8_SB(1, 0), cB + kstep, voffB); PG8_STAGE(PG8_SA(1, 0), cA + kstep, voffA); PG8_STAGE(PG8_SB(1, 1), cB + hstep + kstep, voffB);
        PG8_WAIT_V(6); PG8_BAR;
    } else {
        PG8_STAGE(PG8_SB(0, 0), cB, voffB); PG8_STAGE(PG8_SA(0, 0), cA, voffA); PG8_STAGE(PG8_SB(0, 1), cB + hstep, voffB); PG8_STAGE(PG8_SA(0, 1), cA + hstep, voffA);
        if (wr == 1) PG8_BAR;
        PG8_WAIT_V(4); PG8_BAR;
        PG8_STAGE(PG8_SB(1, 0), cB + kstep, voffB); PG8_STAGE(PG8_SA(1, 0), cA + kstep, voffA); PG8_STAGE(PG8_SB(1, 1), cB + hstep + kstep, voffB);
        PG8_WAIT_V(6); PG8_BAR;
    }
    for (;;) {
        const bool has_next = S.next(ui + 1, nxt);
        const char* nA = has_next ? (const char*)g.A + (size_t)arow(nxt.pm) * (size_t)K * 2 : cA; const char* nB = has_next ? (const char*)g.Bt + (size_t)nxt.pn * tstep : cB;
        for (int t = 0; t < nt; t += 2) {
            const bool last = (t == nt - 2);
            long adjA1 = 0, adjA2 = 0, adjB2 = 0;
            if constexpr (Epi::HAS_MID) { adjA1 = (t >= nt1) ? g.dA - (long)nt1 * (long)kstep : 0; adjA2 = (t + 2 >= nt1) ? g.dA - (long)nt1 * (long)kstep : 0; adjB2 = (t + 2 >= nt1) ? g.dB - (long)nt1 * (long)kstep : 0; }
            if constexpr (Epi::HAS_MID) { if (t == nt1) E.mid(acc, cur, wr, wc, fr, fq); }
            const char* a1 = cA + (size_t)(t + 1) * kstep + adjA1;
            const char* a2 = last ? nA : cA + (size_t)(t + 2) * kstep + adjA2; const char* b2 = last ? nB : cB + (size_t)(t + 2) * kstep + adjB2;
            const char* a3 = a2 + kstep; const char* b3 = b2 + kstep;
            if (last && has_next) S.a_ready(nxt);
            if constexpr (SP2) {
            PG8_LDB(B0, 0, 0); PG8_LDB(B1, 0, 1); PG8_SCHED; PG8_LDA(At, 0, 0); PG8_STAGE(PG8_SA(1, 1), a1 + hstep, voffA);
            PG8_WAIT_V(8); PG8_WAIT_L(0); PG8_BAR; PG8_MMA(0, 0, At, B0); PG8_MMA(0, 1, At, B1); PG8_BAR; PG8_SCHED;
            PG8_LDA(At, 0, 1); PG8_STAGE(PG8_SB(0, 0), b2, voffB); PG8_STAGE(PG8_SB(0, 1), b2 + hstep, voffB); PG8_STAGE(PG8_SA(0, 0), a2, voffA);
            PG8_WAIT_V(8); PG8_WAIT_L(0); PG8_BAR; PG8_MMA(1, 0, At, B0); PG8_MMA(1, 1, At, B1); PG8_BAR; PG8_SCHED;
            PG8_LDB(B0, 1, 0); PG8_LDB(B1, 1, 1); PG8_SCHED; PG8_LDA(At, 1, 0); PG8_STAGE(PG8_SA(0, 1), a2 + hstep, voffA);
            PG8_WAIT_V(8); PG8_WAIT_L(0); PG8_BAR; PG8_MMA(0, 0, At, B0); PG8_MMA(0, 1, At, B1); PG8_BAR; PG8_SCHED;
            PG8_LDA(At, 1, 1); PG8_STAGE(PG8_SB(1, 0), b3, voffB); PG8_STAGE(PG8_SB(1, 1), b3 + hstep, voffB); PG8_STAGE(PG8_SA(1, 0), a3, voffA);
            PG8_WAIT_V(8); PG8_WAIT_L(0); PG8_BAR; PG8_MMA(1, 0, At, B0); PG8_MMA(1, 1, At, B1); PG8_BAR; PG8_SCHED;
            } else {
            PG8_LDB(B0, 0, 0); PG8_SCHED; PG8_LDA(At, 0, 0); PG8_STAGE(PG8_SA(1, 1), a1 + hstep, voffA);
            PG8_WAIT_L(8); PG8_BAR; PG8_WAIT_L(0); PG8_MMA(0, 0, At, B0); PG8_BAR; PG8_SCHED;
            PG8_LDB(B1, 0, 1); PG8_STAGE(PG8_SB(0, 0), b2, voffB);
            PG8_BAR; PG8_WAIT_L(0); PG8_MMA(0, 1, At, B1); PG8_BAR;
            PG8_LDA(At, 0, 1); PG8_STAGE(PG8_SA(0, 0), a2, voffA);
            PG8_BAR; PG8_WAIT_L(0); PG8_MMA(1, 0, At, B0); PG8_BAR; PG8_SCHED;
            PG8_STAGE(PG8_SB(0, 1), b2 + hstep, voffB);
            PG8_WAIT_V(6); PG8_BAR; PG8_MMA(1, 1, At, B1); PG8_BAR;
            PG8_LDB(B0, 1, 0); PG8_SCHED; PG8_LDA(At, 1, 0); PG8_STAGE(PG8_SA(0, 1), a2 + hstep, voffA);
            PG8_WAIT_L(8); PG8_BAR; PG8_WAIT_L(0); PG8_MMA(0, 0, At, B0); PG8_BAR; PG8_SCHED;
            PG8_LDB(B1, 1, 1); PG8_STAGE(PG8_SB(1, 0), b3, voffB);
            PG8_BAR; PG8_WAIT_L(0); PG8_MMA(0, 1, At, B1); PG8_BAR;
            PG8_LDA(At, 1, 1); PG8_STAGE(PG8_SA(1, 0), a3, voffA);
            PG8_BAR; PG8_WAIT_L(0); PG8_MMA(1, 0, At, B0); PG8_BAR; PG8_SCHED;
            PG8_STAGE(PG8_SB(1, 1), b3 + hstep, voffB);
            PG8_WAIT_V(6); PG8_BAR; PG8_MMA(1, 1, At, B1); PG8_BAR;
            }
        }
        if constexpr (ALIGN_EPI) { if (wr == 0) PG8_BAR; }
        if constexpr (!Epi::AFTER_DRAIN) { E(acc, cur, wr, wc, fr, fq); S.done(cur); }
        if (!has_next) break;
#pragma unroll
        for (int a = 0; a < 2; ++a)
#pragma unroll
            for (int b = 0; b < 2; ++b)
#pragma unroll
                for (int m = 0; m < 4; ++m)
#pragma unroll
                    for (int n = 0; n < 2; ++n) acc[a][b][m][n] = (f32x4){0.f, 0.f, 0.f, 0.f};
        cur = nxt; cA = nA; cB = nB; ++ui;
        if constexpr (ALIGN_EPI) { if (wr == 1) PG8_BAR; }
    }
    PG8_WAIT_V(0);
    if constexpr (!ALIGN_EPI) { if (wr == 0) PG8_BAR; }
    PG8_BAR;
    if constexpr (Epi::AFTER_DRAIN) { E.fused(acc, cur, wr, wc, fr, fq, lds, wid, lane); S.done(cur); }
#undef PG8_SA
#undef PG8_SB
#undef PG8_STAGE
#undef PG8_LDA
#undef PG8_LDB
#undef PG8_MMA
#undef PG8_WAIT_V
#undef PG8_WAIT_L
#undef PG8_BAR
#undef PG8_SCHED
}
}

namespace pg8 {
typedef unsigned u32x2 __attribute__((ext_vector_type(2)));
__device__ __forceinline__ float sigm(float x) { return __builtin_amdgcn_rcpf(1.0f + __expf(-x)); }
__device__ __forceinline__ void unpack8(const u32x4 w, float (&f)[8]) {
#pragma unroll
    for (int i = 0; i < 4; ++i) { f[2 * i] = __uint_as_float(w[i] << 16); f[2 * i + 1] = __uint_as_float(w[i] & 0xffff0000u); }
}
__device__ __forceinline__ u32x4 pack8f(const f32x4 a, const f32x4 b) { u32x4 w; w.x = cvt_pk_bf16(a[0], a[1]); w.y = cvt_pk_bf16(a[2], a[3]); w.z = cvt_pk_bf16(b[0], b[1]); w.w = cvt_pk_bf16(b[2], b[3]); return w; }
#define EPI_LOOP_AM _Pragma("unroll") for (int ai = 0; ai < 2; ++ai) _Pragma("unroll") for (int m = 0; m < 4; ++m)

__device__ __forceinline__ float dpp_shr1(float old, float x) { return __builtin_bit_cast(float, __builtin_amdgcn_update_dpp(__builtin_bit_cast(int, old), __builtin_bit_cast(int, x), 0x111, 0xf, 0xf, false)); }
__device__ __forceinline__ float dpp_shr2(float old, float x) { return __builtin_bit_cast(float, __builtin_amdgcn_update_dpp(__builtin_bit_cast(int, old), __builtin_bit_cast(int, x), 0x112, 0xf, 0xf, false)); }
__device__ __forceinline__ float dpp_ror1(float x) { return __builtin_bit_cast(float, __builtin_amdgcn_update_dpp(0, __builtin_bit_cast(int, x), 0x121, 0xf, 0xf, false)); }
__device__ __forceinline__ float dpp_ror2(float x) { return __builtin_bit_cast(float, __builtin_amdgcn_update_dpp(0, __builtin_bit_cast(int, x), 0x122, 0xf, 0xf, false)); }
struct EpiProj {
    static constexpr bool PERM = true, AFTER_DRAIN = false, HAS_MID = false;
    bf16_t *Q; size_t qkv_stride; bf16_t *YC, *GA, *GC; const float* cw;     float *CUHEAD, *GBHEAD, *CUTAIL; PG8_LAS float* halo;
    __device__ __forceinline__ void operator()(const f32x4 (&acc)[2][2][4][2], const Unit& u, int wr, int wc, int fr, int fq) const {
        const int row0 = arow(u.pm) + wr * 64 + fr; const int pn = u.pn;
        if (pn < 12) {
            bf16_t* base = Q + (size_t)(pn >> 2) * qkv_stride; const int col0 = (pn & 3) * 256 + wc * 32 + 8 * fq;
            EPI_LOOP_AM { bf16_t* rowp = base + (size_t)(row0 + ai * HALF + m * 16) * 1024 + col0;
#pragma unroll
                for (int bj = 0; bj < 2; ++bj) *(u32x4*)(rowp + bj * HALF) = pack8f(acc[ai][bj][m][0], acc[ai][bj][m][1]); }
        } else if (pn < 28) {
            const int lch = 16 * wc + 4 * fq, ch0 = 64 * (pn - 12) + lch;
            f32x4 cu[2][4];
            EPI_LOOP_AM cu[ai][m] = acc[ai][0][m][1] * acc[ai][1][m][0];
            if (fr >= 14) {
#pragma unroll
                for (int ai = 0; ai < 2; ++ai) *(PG8_LAS f32x4*)(halo + ((2 * ai + wr) * 2 + (fr - 14)) * 64 + lch) = cu[ai][3];
                if (wr == 1) *(f32x4*)(CUTAIL + ((size_t)u.pm * 2 + (fr - 14)) * 1024 + ch0) = cu[1][3];
            }
            if (fr < 2 && wr == 0) { *(f32x4*)(CUHEAD + ((size_t)u.pm * 2 + fr) * 1024 + ch0) = cu[0][0]; *(f32x4*)(GBHEAD + ((size_t)u.pm * 2 + fr) * 1024 + ch0) = acc[0][0][0][0]; }
            const f32x4 w0 = *(const f32x4*)(cw + ch0), w1 = *(const f32x4*)(cw + 1024 + ch0), w2 = *(const f32x4*)(cw + 2048 + ch0);
            asm volatile("s_waitcnt lgkmcnt(0)" ::: "memory"); __builtin_amdgcn_s_barrier(); asm volatile("" ::: "memory");
#pragma unroll
            for (int ai = 0; ai < 2; ++ai) { const int sl = 2 * ai + wr;
#pragma unroll
                for (int m = 0; m < 4; ++m) { f32x4 h1 = {0.f, 0.f, 0.f, 0.f}, h2 = h1, yc, gg;
                    if (m == 0 && sl > 0) { h2 = *(const PG8_LAS f32x4*)(halo + ((sl - 1) * 2 + 0) * 64 + lch); h1 = *(const PG8_LAS f32x4*)(halo + ((sl - 1) * 2 + 1) * 64 + lch); }
#pragma unroll
                    for (int e = 0; e < 4; ++e) { const float x = cu[ai][m][e]; float o1, o2;
                        if (m == 0) { o1 = h1[e]; o2 = (fr == 0) ? h2[e] : h1[e]; } else { const float g = cu[ai][m - 1][e]; o1 = dpp_ror1(g); o2 = dpp_ror2(g); }
                        const float p1 = dpp_shr1(o1, x), p2 = dpp_shr2(o2, x);
                        yc[e] = acc[ai][0][m][0][e] * (w0[e] * p2 + w1[e] * p1 + w2[e] * x); gg[e] = sigm(acc[ai][1][m][1][e]); }
                    const size_t off = (size_t)(row0 + ai * HALF + m * 16) * 1024 + ch0;
                    u32x2 oy, og; oy.x = cvt_pk_bf16(yc[0], yc[1]); oy.y = cvt_pk_bf16(yc[2], yc[3]); og.x = cvt_pk_bf16(gg[0], gg[1]); og.y = cvt_pk_bf16(gg[2], gg[3]);
                    *(u32x2*)(YC + off) = oy; *(u32x2*)(GC + off) = og; } }
        } else {
            const int col0 = (pn - 28) * 256 + wc * 32 + 8 * fq;
            EPI_LOOP_AM { bf16_t* rowp = GA + (size_t)(row0 + ai * HALF + m * 16) * 1024 + col0;
#pragma unroll
                for (int bj = 0; bj < 2; ++bj) { f32x4 a = acc[ai][bj][m][0], bb = acc[ai][bj][m][1];
#pragma unroll
                    for (int e = 0; e < 4; ++e) { a[e] = sigm(a[e]); bb[e] = sigm(bb[e]); }
                    *(u32x4*)(rowp + bj * HALF) = pack8f(a, bb); } }
        }
    }
};
template <bool ADD> struct EpiGate {
    static constexpr bool PERM = true, AFTER_DRAIN = false, HAS_MID = false;
    const bf16_t* G; const bf16_t* Tin; bf16_t* O;
    __device__ __forceinline__ void operator()(const f32x4 (&acc)[2][2][4][2], const Unit& u, int wr, int wc, int fr, int fq) const {
        const int row0 = arow(u.pm) + wr * 64 + fr; const int col0 = u.pn * 256 + wc * 32 + 8 * fq;
        EPI_LOOP_AM { const size_t off = (size_t)(row0 + ai * HALF + m * 16) * 1024 + col0;
#pragma unroll
            for (int bj = 0; bj < 2; ++bj) { float g[8]; unpack8(*(const u32x4*)(G + off + bj * HALF), g);
                f32x4 a = acc[ai][bj][m][0], b = acc[ai][bj][m][1];
#pragma unroll
                for (int e = 0; e < 4; ++e) { a[e] *= g[e]; b[e] *= g[4 + e]; }
                if (ADD) { float t[8]; unpack8(*(const u32x4*)(Tin + off + bj * HALF), t);
#pragma unroll
                    for (int e = 0; e < 4; ++e) { a[e] += t[e]; b[e] += t[4 + e]; } }
                *(u32x4*)(O + off + bj * HALF) = pack8f(a, b); } }
    }
};
struct EpiRes {
    static constexpr bool PERM = true, AFTER_DRAIN = false, HAS_MID = false;
    const float* base; float* out;
    __device__ __forceinline__ void operator()(const f32x4 (&acc)[2][2][4][2], const Unit& u, int wr, int wc, int fr, int fq) const {
        const int row0 = u.pm * 256 + wr * 64 + fr; const int col0 = u.pn * 256 + wc * 32 + 8 * fq;
        EPI_LOOP_AM { const size_t off = (size_t)(row0 + ai * HALF + m * 16) * 1024 + col0;
#pragma unroll
            for (int bj = 0; bj < 2; ++bj) { const f32x4 x0 = *(const f32x4*)(base + off + bj * HALF), x1 = *(const f32x4*)(base + off + bj * HALF + 4);
                *(f32x4*)(out + off + bj * HALF) = x0 + acc[ai][bj][m][0]; *(f32x4*)(out + off + bj * HALF + 4) = x1 + acc[ai][bj][m][1]; } }
    }
};
struct EpiResSS {
    static constexpr bool PERM = true, AFTER_DRAIN = false, HAS_MID = false;
    const float* base; float* out; bf16_t* Zb; float* SS;
    __device__ __forceinline__ void operator()(const f32x4 (&acc)[2][2][4][2], const Unit& u, int wr, int wc, int fr, int fq) const {
        const int row0 = u.pm * 256 + wr * 64 + fr; const int col0 = u.pn * 256 + wc * 32 + 8 * fq; const int brow0 = arow(u.pm) + wr * 64 + fr;
        EPI_LOOP_AM { const size_t off = (size_t)(row0 + ai * HALF + m * 16) * 1024 + col0; const size_t boff = (size_t)(brow0 + ai * HALF + m * 16) * 1024 + col0; float s = 0.f;
#pragma unroll
            for (int bj = 0; bj < 2; ++bj) { const f32x4 z0 = *(const f32x4*)(base + off + bj * HALF) + acc[ai][bj][m][0], z1 = *(const f32x4*)(base + off + bj * HALF + 4) + acc[ai][bj][m][1];
                *(u32x4*)(Zb + boff + bj * HALF) = pack8f(z0, z1);
                s += ((z0[0] * z0[0] + z0[1] * z0[1]) + (z0[2] * z0[2] + z0[3] * z0[3])) + ((z1[0] * z1[0] + z1[1] * z1[1]) + (z1[2] * z1[2] + z1[3] * z1[3])); }
            s += __shfl_xor(s, 16); s += __shfl_xor(s, 32);
            if (fq == 0) atomicAdd(SS + row0 + ai * HALF + m * 16, s); }
    }
};
struct EpiFfn {
    static constexpr bool PERM = true, AFTER_DRAIN = false, HAS_MID = false;
    bf16_t *Ab, *Vb; const float* SS;
    __device__ __forceinline__ void operator()(const f32x4 (&acc)[2][2][4][2], const Unit& u, int wr, int wc, int fr, int fq) const {
        const int row0 = arow(u.pm) + wr * 64 + fr; const int col0 = u.pn * 128 + wc * 32 + 8 * fq; const int srow0 = u.pm * 256 + wr * 64 + fr;
        EPI_LOOP_AM { const size_t off = (size_t)(row0 + ai * HALF + m * 16) * 2816 + col0; const float rs = 1.0f / sqrtf(SS[srow0 + ai * HALF + m * 16] * (1.0f / 1024.0f) + 1e-6f);
            *(u32x4*)(Ab + off) = pack8f(acc[ai][0][m][0] * rs, acc[ai][0][m][1] * rs); *(u32x4*)(Vb + off) = pack8f(acc[ai][1][m][0] * rs, acc[ai][1][m][1] * rs); }
    }
};
struct EpiFfnConv {
    static constexpr bool PERM = true, AFTER_DRAIN = false, HAS_MID = false;
    bf16_t* Sb; const float* SS; const float* cw; float *AHEAD, *VHEAD, *ATAIL; PG8_LAS float* halo;
    __device__ __forceinline__ void operator()(const f32x4 (&acc)[2][2][4][2], const Unit& u, int wr, int wc, int fr, int fq) const {
        const int row0 = arow(u.pm) + wr * 64 + fr, chan0 = u.pn * 128 + wc * 32 + 8 * fq, srow0 = u.pm * 256 + wr * 64 + fr, lcol = wc * 32 + 8 * fq;
        f32x4 av[2][4][2]; float rs[2][4];
        EPI_LOOP_AM { rs[ai][m] = 1.0f / sqrtf(SS[srow0 + ai * HALF + m * 16] * (1.0f / 1024.0f) + 1e-6f); av[ai][m][0] = acc[ai][0][m][0] * rs[ai][m]; av[ai][m][1] = acc[ai][0][m][1] * rs[ai][m]; }
        if (fr >= 14) {
#pragma unroll
            for (int ai = 0; ai < 2; ++ai)
#pragma unroll
                for (int n = 0; n < 2; ++n) *(PG8_LAS f32x4*)(halo + ((2 * ai + wr) * 2 + (fr - 14)) * 128 + lcol + 4 * n) = av[ai][3][n];
            if (wr == 1) {
#pragma unroll
                for (int n = 0; n < 2; ++n) *(f32x4*)(ATAIL + ((size_t)u.pm * 2 + (fr - 14)) * 2816 + chan0 + 4 * n) = av[1][3][n]; }
        }
        if (fr < 2 && wr == 0) {
#pragma unroll
            for (int n = 0; n < 2; ++n) { *(f32x4*)(AHEAD + ((size_t)u.pm * 2 + fr) * 2816 + chan0 + 4 * n) = av[0][0][n]; *(f32x4*)(VHEAD + ((size_t)u.pm * 2 + fr) * 2816 + chan0 + 4 * n) = acc[0][1][0][n] * rs[0][0]; } }
        f32x4 w0[2], w1[2], w2[2];
#pragma unroll
        for (int n = 0; n < 2; ++n) { w0[n] = *(const f32x4*)(cw + chan0 + 4 * n); w1[n] = *(const f32x4*)(cw + 2816 + chan0 + 4 * n); w2[n] = *(const f32x4*)(cw + 2 * 2816 + chan0 + 4 * n); }
        asm volatile("s_waitcnt lgkmcnt(0)" ::: "memory"); __builtin_amdgcn_s_barrier(); asm volatile("" ::: "memory");
#pragma unroll
        for (int ai = 0; ai < 2; ++ai) {
            const int sl = 2 * ai + wr;
#pragma unroll
            for (int m = 0; m < 4; ++m) { f32x4 sv[2];
#pragma unroll
                for (int n = 0; n < 2; ++n) { f32x4 h1, h2;
                    if (m == 0) { if (sl > 0) { h2 = *(const PG8_LAS f32x4*)(halo + ((sl - 1) * 2 + 0) * 128 + lcol + 4 * n); h1 = *(const PG8_LAS f32x4*)(halo + ((sl - 1) * 2 + 1) * 128 + lcol + 4 * n); } else { h1 = (f32x4){0.f, 0.f, 0.f, 0.f}; h2 = h1; } }
#pragma unroll
                    for (int e = 0; e < 4; ++e) { const float x = av[ai][m][n][e]; float o1, o2;
                        if (m == 0) { o1 = h1[e]; o2 = (fr == 0) ? h2[e] : h1[e]; } else { const float g = av[ai][m - 1][n][e]; o1 = dpp_ror1(g); o2 = dpp_ror2(g); }
                        const float p1 = dpp_shr1(o1, x), p2 = dpp_shr2(o2, x);
                        const float cv = w0[n][e] * p2 + w1[n][e] * p1 + w2[n][e] * x;
                        sv[n][e] = cv * sigm(cv) * (acc[ai][1][m][n][e] * rs[ai][m]); } }
                *(u32x4*)(Sb + (size_t)(row0 + ai * HALF + m * 16) * 2816 + chan0) = pack8f(sv[0], sv[1]); } }
    }
};
struct EpiResNorm {
    static constexpr bool PERM = true, AFTER_DRAIN = false, HAS_MID = false;
    const bf16_t* base; float* out; const float* g; float* xb; unsigned* cnt; PG8_LAS float* P; PG8_LAS float* Srow;
    __device__ __forceinline__ void operator()(f32x4 (&acc)[2][2][4][2], const Unit& u, int wr, int wc, int fr, int fq) const {
        const int row0 = u.pm * 256 + wr * 64 + fr; const int col0 = u.pn * 256 + wc * 32 + 8 * fq; const int tid = threadIdx.x, wid = tid >> 6, lane = tid & 63; const int brow0 = arow(u.pm) + wr * 64 + fr;
        EPI_LOOP_AM { const size_t boff = (size_t)(brow0 + ai * HALF + m * 16) * 1024 + col0; float s = 0.f;
#pragma unroll
            for (int bj = 0; bj < 2; ++bj) { float zb[8]; unpack8(*(const u32x4*)(base + boff + bj * HALF), zb);
                acc[ai][bj][m][0] += (f32x4){zb[0], zb[1], zb[2], zb[3]}; acc[ai][bj][m][1] += (f32x4){zb[4], zb[5], zb[6], zb[7]};
                const f32x4 z0 = acc[ai][bj][m][0], z1 = acc[ai][bj][m][1];
                s += ((z0[0] * z0[0] + z0[1] * z0[1]) + (z0[2] * z0[2] + z0[3] * z0[3])) + ((z1[0] * z1[0] + z1[1] * z1[1]) + (z1[2] * z1[2] + z1[3] * z1[3])); }
            s += __shfl_xor(s, 16); s += __shfl_xor(s, 32);
            if (fq == 0) P[(ai * HALF + wr * 64 + m * 16 + fr) * 4 + wc] = s; }
        asm volatile("s_waitcnt lgkmcnt(0)" ::: "memory"); __builtin_amdgcn_s_barrier(); asm volatile("" ::: "memory");
        if (tid < 256) { const f32x4 p = *(const PG8_LAS f32x4*)(P + tid * 4);
            __hip_atomic_store(xb + ((size_t)u.pm * 256 + tid) * 4 + u.pn, (p[0] + p[1]) + (p[2] + p[3]), __ATOMIC_RELAXED, __HIP_MEMORY_SCOPE_AGENT);
            asm volatile("s_waitcnt vmcnt(0)" ::: "memory");
            if (lane == 0) __hip_atomic_fetch_add(cnt + 64 * u.pm, 1u, __ATOMIC_RELAXED, __HIP_MEMORY_SCOPE_AGENT); }
        if (wid == 0) { unsigned sp = 0;
            while ((unsigned)__builtin_amdgcn_readfirstlane(__hip_atomic_load(cnt + 64 * u.pm, __ATOMIC_RELAXED, __HIP_MEMORY_SCOPE_AGENT)) < 16u) { __builtin_amdgcn_s_sleep(2); if (++sp > (1u << 22)) break; }
            __builtin_amdgcn_fence(__ATOMIC_ACQUIRE, "agent"); }
        asm volatile("s_waitcnt vmcnt(0) lgkmcnt(0)" ::: "memory"); __builtin_amdgcn_s_barrier(); asm volatile("" ::: "memory");
        if (tid < 256) { const float* sl = xb + ((size_t)u.pm * 256 + tid) * 4; float t = 0.f;
#pragma unroll
            for (int k = 0; k < 4; ++k) t += __hip_atomic_load(sl + k, __ATOMIC_RELAXED, __HIP_MEMORY_SCOPE_AGENT);
            Srow[tid] = 1.0f / sqrtf(t * (1.0f / 1024.0f) + 1e-6f); }
        asm volatile("s_waitcnt lgkmcnt(0)" ::: "memory"); __builtin_amdgcn_s_barrier(); asm volatile("" ::: "memory");
        f32x4 gv[2][2];
#pragma unroll
        for (int bj = 0; bj < 2; ++bj) { gv[bj][0] = *(const f32x4*)(g + col0 + bj * HALF); gv[bj][1] = *(const f32x4*)(g + col0 + bj * HALF + 4); }
        EPI_LOOP_AM { const int r = ai * HALF + wr * 64 + m * 16 + fr; const float rs = Srow[r]; const size_t off = (size_t)(row0 + ai * HALF + m * 16) * 1024 + col0;
#pragma unroll
            for (int bj = 0; bj < 2; ++bj) { *(f32x4*)(out + off + bj * HALF) = (acc[ai][bj][m][0] * rs) * gv[bj][0]; *(f32x4*)(out + off + bj * HALF + 4) = (acc[ai][bj][m][1] * rs) * gv[bj][1]; } }
    }
};
struct EpiGate2 {
    static constexpr bool PERM = true, AFTER_DRAIN = false, HAS_MID = true;
    const bf16_t* GA; const bf16_t* GC; bf16_t* O;
    __device__ __forceinline__ void mid(f32x4 (&acc)[2][2][4][2], const Unit& u, int wr, int wc, int fr, int fq) const {
        int frE = fr, fqE = fq; asm volatile("" : "+v"(frE), "+v"(fqE));
        const int row0 = arow(u.pm) + wr * 64 + frE; const int col0 = u.pn * 256 + wc * 32 + 8 * fqE;
        EPI_LOOP_AM { const size_t off = (size_t)(row0 + ai * HALF + m * 16) * 1024 + col0;
#pragma unroll
            for (int bj = 0; bj < 2; ++bj) { float ga[8], gc[8]; unpack8(*(const u32x4*)(GA + off + bj * HALF), ga); unpack8(*(const u32x4*)(GC + off + bj * HALF), gc);
#pragma unroll
                for (int e = 0; e < 4; ++e) { acc[ai][bj][m][0][e] *= ga[e] * __builtin_amdgcn_rcpf(gc[e]); acc[ai][bj][m][1][e] *= ga[4 + e] * __builtin_amdgcn_rcpf(gc[4 + e]); } }
            asm volatile("" ::: "memory"); }
    }
    __device__ __forceinline__ void operator()(const f32x4 (&acc)[2][2][4][2], const Unit& u, int wr, int wc, int fr, int fq) const {
        int frE = fr, fqE = fq; asm volatile("" : "+v"(frE), "+v"(fqE));
        const int row0 = arow(u.pm) + wr * 64 + frE; const int col0 = u.pn * 256 + wc * 32 + 8 * fqE;
        EPI_LOOP_AM { const size_t off = (size_t)(row0 + ai * HALF + m * 16) * 1024 + col0;
#pragma unroll
            for (int bj = 0; bj < 2; ++bj) { float gc[8]; unpack8(*(const u32x4*)(GC + off + bj * HALF), gc);
                f32x4 a = acc[ai][bj][m][0], bb = acc[ai][bj][m][1];
#pragma unroll
                for (int e = 0; e < 4; ++e) { a[e] *= gc[e]; bb[e] *= gc[4 + e]; }
                *(u32x4*)(O + off + bj * HALF) = pack8f(a, bb); } }
    }
};
}

namespace att {
constexpr int D = 128, RS = 1024;
constexpr float THR = 8.f;
constexpr bool WSKIP = false;
constexpr float SCALE = 0.08838834764831845f, INV_SCALE = 11.313708498984761f;
constexpr int NW = 8, QBLK = 32, KVBLK = 64, QB = NW * QBLK;
constexpr int SHM_V = KVBLK * D * 2, SHM_K = KVBLK * D * 2;
constexpr int BIAS_OFF = 2 * SHM_K + NW * 64 * 4;
constexpr int LDS_BYTES = 2 * SHM_V + 2 * SHM_K + NW * 64 * 4 + 2 * 64 * 4;
using bf16 = __hip_bfloat16;
typedef short bf16x8 __attribute__((ext_vector_type(8)));
typedef short s16x4 __attribute__((ext_vector_type(4)));
typedef float f32x16 __attribute__((ext_vector_type(16)));
typedef float f32x4 __attribute__((ext_vector_type(4)));
typedef unsigned u32x4 __attribute__((ext_vector_type(4)));
template <class A, class Bt> struct same_t { static constexpr bool v = false; };
template <class A> struct same_t<A, A> { static constexpr bool v = true; };
#define KSWZ(row, colB) ((row) * 256 + ((colB) ^ (((row) & 7) << 4)))
#define SBAR() __builtin_amdgcn_sched_barrier(0)
__device__ __forceinline__ int v_st(int k, int c) { const int kk = (k & ~0xC) | ((k & 4) << 1) | ((k & 8) >> 1); return ((kk >> 3) * 4 + (c >> 5)) * 512 + ((kk & 7) * 32 + (c & 31)) * 2; }
__device__ __forceinline__ int v_rd_base(int lane) { return ((lane & 3) << 3) | (((lane >> 2) & 3) << 6) | (((lane >> 4) & 1) << 5) | (((lane >> 5) & 1) << 8); }
constexpr int v_rd_off(int d0, int ks, int half) { return d0 * 512 + ks * 4096 + half * 2048; }
__device__ __forceinline__ int crow(int r, int hi) { return (r & 3) + 8 * (r >> 2) + 4 * hi; }
__device__ __forceinline__ unsigned cvtpk(float lo, float hi) {
    unsigned r; asm volatile("v_cvt_pk_bf16_f32 %0, %1, %2" : "=v"(r) : "v"(lo), "v"(hi)); return r;
}
__device__ __forceinline__ bf16x8 pack8(f32x4 a, f32x4 b) {
    u32x4 w = {cvtpk(a[0], a[1]), cvtpk(a[2], a[3]), cvtpk(b[0], b[1]), cvtpk(b[2], b[3])};
    return *reinterpret_cast<bf16x8*>(&w);
}
template <class T> __device__ __forceinline__ bf16x8 load8(const T* p) {
    if constexpr (same_t<T, float>::v) { return pack8(*(const f32x4*)p, *(const f32x4*)(p + 4)); }
    else { return *reinterpret_cast<const bf16x8*>(p); }
}
__device__ __forceinline__ void mask_tile(f32x16& p0, f32x16& p1, int dq, unsigned W) {
    const float NEG = -__builtin_inff();
#pragma unroll
    for (int r = 0; r < 16; ++r) {
        const int c = (r & 3) + 8 * (r >> 2);
        if ((unsigned)(dq - c) >= W) p0[r] = NEG;
        if ((unsigned)(dq - c - 32) >= W) p1[r] = NEG;
    }
}
__device__ __forceinline__ void partialSM(f32x16& p0, f32x16& p1, float& m_reg, float& mn, float& alpha) {
    float pmax = p0[0]; for (int r = 1; r < 16; ++r) pmax = fmaxf(pmax, p0[r]); for (int r = 0; r < 16; ++r) pmax = fmaxf(pmax, p1[r]);
    { auto rr = __builtin_amdgcn_permlane32_swap(__float_as_uint(pmax), __float_as_uint(pmax), false, false);
      pmax = fmaxf(__uint_as_float(rr[0]), __uint_as_float(rr[1])); }
    constexpr float C2 = 1.4426950408889634f * SCALE;
    if (__builtin_expect(__all((pmax - m_reg) * SCALE <= THR), 1)) { mn = m_reg; alpha = 1.f; }
    else { mn = fmaxf(m_reg, pmax); alpha = __builtin_amdgcn_exp2f((m_reg - mn) * C2); m_reg = mn; }
    const float mnL = -mn * C2;
    for (int r = 0; r < 16; ++r) p0[r] = fmaf(p0[r], C2, mnL); for (int r = 0; r < 16; ++r) p1[r] = fmaf(p1[r], C2, mnL);
    for (int r = 0; r < 16; ++r) p0[r] = __builtin_amdgcn_exp2f(p0[r]);
}
__device__ __forceinline__ void finishSM(f32x16& p0, f32x16& p1, float alpha, float& l_reg, bf16x8& pa0, bf16x8& pa1, bf16x8& pa2, bf16x8& pa3) {
    for (int r = 0; r < 16; ++r) p1[r] = __builtin_amdgcn_exp2f(p1[r]);
    float ps = 0; for (int r = 0; r < 16; ++r) ps += p0[r]; for (int r = 0; r < 16; ++r) ps += p1[r];
    { auto rr = __builtin_amdgcn_permlane32_swap(__float_as_uint(ps), __float_as_uint(ps), false, false);
      ps = __uint_as_float(rr[0]) + __uint_as_float(rr[1]); }
    l_reg = l_reg * alpha + ps;
#define PK4(P, B_, OUT) do { unsigned a0 = cvtpk(P[B_+0], P[B_+1]), a1 = cvtpk(P[B_+2], P[B_+3]);                          \
        unsigned b0 = cvtpk(P[B_+4], P[B_+5]), b1 = cvtpk(P[B_+6], P[B_+7]);                                             \
        auto r0 = __builtin_amdgcn_permlane32_swap(a0, b0, false, false); auto r1 = __builtin_amdgcn_permlane32_swap(a1, b1, false, false); \
        u32x4 w = {r0[0], r1[0], r0[1], r1[1]}; OUT = *reinterpret_cast<bf16x8*>(&w); } while (0)
    PK4(p0, 0, pa0); PK4(p0, 8, pa1); PK4(p1, 0, pa2); PK4(p1, 8, pa3);
#undef PK4
}
template <int KB, bool SK>
__device__ __forceinline__ void qkt(f32x16& p0, f32x16& p1, const char* K_lds, int r32, int hi, const bf16x8* qr, bool act) {
    if (SK && !act) { const float NEG = -__builtin_inff();
#pragma unroll
        for (int r = 0; r < 16; ++r) { p0[r] = NEG; p1[r] = NEG; } return; }
    { unsigned ba_; asm volatile("v_lshl_add_u32 %0, %1, 4, %2" : "=v"(ba_) : "v"(hi), "s"((unsigned)(uintptr_t)(K_lds + BIAS_OFF + KB * 256)));
      const __attribute__((address_space(3))) float* bl = (const __attribute__((address_space(3))) float*)(uintptr_t)ba_;
#pragma unroll
      for (int g_ = 0; g_ < 4; ++g_) { const f32x4 a_ = *(const __attribute__((address_space(3))) f32x4*)(bl + 8 * g_), b_ = *(const __attribute__((address_space(3))) f32x4*)(bl + 32 + 8 * g_);
        p0[4 * g_] = a_[0]; p0[4 * g_ + 1] = a_[1]; p0[4 * g_ + 2] = a_[2]; p0[4 * g_ + 3] = a_[3]; p1[4 * g_] = b_[0]; p1[4 * g_ + 1] = b_[1]; p1[4 * g_ + 2] = b_[2]; p1[4 * g_ + 3] = b_[3]; } }
    const unsigned kb0 = (unsigned)(uintptr_t)(K_lds + KSWZ(r32, (hi * 8) * 2));
#pragma unroll
    for (int d0 = 0; d0 < 8; ++d0) { unsigned ax = kb0; if (d0 & 3) asm volatile("v_xor_b32_e32 %0, %2, %1" : "=v"(ax) : "v"(kb0), "n"((d0 & 3) << 5));
        const __attribute__((address_space(3))) char* a = (const __attribute__((address_space(3))) char*)(uintptr_t)ax + KB * SHM_K + (d0 >> 2) * 128;
        bf16x8 b0 = *(const __attribute__((address_space(3))) bf16x8*)(a);
        bf16x8 b1 = *(const __attribute__((address_space(3))) bf16x8*)(a + 32 * 256);
        p0 = __builtin_amdgcn_mfma_f32_32x32x16_bf16(b0, qr[d0], p0, 0, 0, 0);
        p1 = __builtin_amdgcn_mfma_f32_32x32x16_bf16(b1, qr[d0], p1, 0, 0, 0); }
}
template <int VB, bool SK>
__device__ __forceinline__ void pv_tile(f32x16* o, int vb0, bf16x8 pa0, bf16x8 pa1, bf16x8 pa2, bf16x8 pa3, bool act) {
    if (SK && !act) return;
#define TRRD(dst, off) asm volatile("ds_read_b64_tr_b16 %0, %1 offset:%2" : "=&v"(dst) : "v"(vb0), "i"(off) : "memory")
#define PV_D0(d0) do { s16x4 l0, l1, l2, l3, h0, h1, h2, h3; constexpr int b_ = VB * SHM_V + v_rd_off(d0, 0, 0);     \
        TRRD(l0, b_); TRRD(h0, b_ + 2048); TRRD(l1, b_ + 4096); TRRD(h1, b_ + 6144); TRRD(l2, b_ + 8192); TRRD(h2, b_ + 10240); TRRD(l3, b_ + 12288); TRRD(h3, b_ + 14336); \
        asm volatile("s_waitcnt lgkmcnt(0)" ::: "memory"); SBAR();                 \
        o[d0] = __builtin_amdgcn_mfma_f32_32x32x16_bf16(pa0, (bf16x8){l0[0], l0[1], l0[2], l0[3], h0[0], h0[1], h0[2], h0[3]}, o[d0], 0, 0, 0);   \
        o[d0] = __builtin_amdgcn_mfma_f32_32x32x16_bf16(pa1, (bf16x8){l1[0], l1[1], l1[2], l1[3], h1[0], h1[1], h1[2], h1[3]}, o[d0], 0, 0, 0);   \
        o[d0] = __builtin_amdgcn_mfma_f32_32x32x16_bf16(pa2, (bf16x8){l2[0], l2[1], l2[2], l2[3], h2[0], h2[1], h2[2], h2[3]}, o[d0], 0, 0, 0);   \
        o[d0] = __builtin_amdgcn_mfma_f32_32x32x16_bf16(pa3, (bf16x8){l3[0], l3[1], l3[2], l3[3], h3[0], h3[1], h3[2], h3[3]}, o[d0], 0, 0, 0); } while (0)
    PV_D0(0); PV_D0(1); PV_D0(2); PV_D0(3);
#undef PV_D0
#undef TRRD
}

template <class TIn, class TOut> struct BlockRef { const TIn* Q; const TIn* K; const TIn* V; TOut* O; const float* C; int P0; };
template <class TIn> struct Seam {
    bf16x8 qr[8];
    bf16x8 st_v0, st_v1, st_k0, st_k1; f32x4 sf0, sf1, sf2, sf3; float st_b;
    f32x4 tq[16];
};
__device__ __forceinline__ int swa_jlo(int P0, int W) { const int lowk = P0 - W + 1; return lowk > 0 ? lowk / KVBLK : 0; }
#define ROW(p, k0, rr) ((p) + (size_t)((k0) + (rr)) * RS + sc)
#define VMW() asm volatile("s_waitcnt vmcnt(0)" ::: "memory")
#define VMWN(n) asm volatile("s_waitcnt vmcnt(%0)" :: "i"(n) : "memory")
#define SLOAD_H(Kp, Vp, k0) do { S.st_v0 = load8<TIn>(ROW(Vp, k0, sr)); S.st_v1 = load8<TIn>(ROW(Vp, k0, 32 + sr));              \
                         S.st_k0 = load8<TIn>(ROW(Kp, k0, sr)); S.st_k1 = load8<TIn>(ROW(Kp, k0, 32 + sr)); } while (0)
#define SLOAD_B(Cp, cref, k0) do { S.st_b = (Cp)[(k0) + lane]; } while (0)
#define SWRITE_B(bf) do { unsigned wa_; asm volatile("v_lshl_add_u32 %0, %1, 2, %2" : "=v"(wa_) : "v"(lane), "s"((unsigned)(uintptr_t)(K_lds + BIAS_OFF))); ((__attribute__((address_space(3))) float*)(uintptr_t)wa_)[(bf) * 64] = S.st_b; } while (0)
#define SWRITE_HK(bf) do { *(bf16x8*)(K_lds + (bf) * SHM_K + kws) = S.st_k0; *(bf16x8*)(K_lds + (bf) * SHM_K + kws + 32 * 256) = S.st_k1; SWRITE_B(bf); } while (0)
#define SWRITE_HV(bf) do { *(bf16x8*)(V_lds + (bf) * SHM_V + vst0) = S.st_v0; *(bf16x8*)(V_lds + (bf) * SHM_V + vst0 + vst1_d) = S.st_v1; } while (0)
#define SWRITE_H(bf) do { SWRITE_HV(bf); SWRITE_HK(bf); } while (0)
#define SLOAD_F(p, k0) do { S.sf0 = *(const f32x4*)ROW(p, k0, sr); S.sf1 = *(const f32x4*)(ROW(p, k0, sr) + 4);                \
                            S.sf2 = *(const f32x4*)ROW(p, k0, 32 + sr); S.sf3 = *(const f32x4*)(ROW(p, k0, 32 + sr) + 4); } while (0)
#define SWRITE_KF(bf) do { *(bf16x8*)(K_lds + (bf) * SHM_K + kws) = pack8(S.sf0, S.sf1); *(bf16x8*)(K_lds + (bf) * SHM_K + kws + 32 * 256) = pack8(S.sf2, S.sf3); } while (0)
#define SWRITE_VF(bf) do { *(bf16x8*)(V_lds + (bf) * SHM_V + vst0) = pack8(S.sf0, S.sf1); *(bf16x8*)(V_lds + (bf) * SHM_V + vst0 + vst1_d) = pack8(S.sf2, S.sf3); } while (0)
template <class TIn, class TOut>
__device__ __forceinline__ void causal_swa_prime(const BlockRef<TIn, TOut>& cur, int W, char* lds, Seam<TIn>& S) {
    constexpr bool F32 = same_t<TIn, float>::v;
    const int tid = threadIdx.x, wid = __builtin_amdgcn_readfirstlane(tid >> 6), lane = tid & 63, r32 = lane & 31, hi = lane >> 5;
    const int sr = tid >> 4, sc = (tid & 15) * 8, kws = KSWZ(sr, sc * 2); char* K_lds = lds + 2 * SHM_V;
    const int kb0 = ((cur.P0 + QB - 1) / KVBLK) * KVBLK;
    for (int d0 = 0; d0 < 8; ++d0) S.qr[d0] = load8<TIn>(cur.Q + (size_t)(wid * QBLK + r32) * RS + d0 * 16 + hi * 8);
    if constexpr (F32) { SLOAD_F((const float*)cur.K, kb0); VMW(); SWRITE_KF(0); SBAR(); SLOAD_F((const float*)cur.V, kb0); }
    else { SLOAD_H(cur.K, cur.V, kb0); SLOAD_B(cur.C, 0, kb0); VMW(); SWRITE_HK(0); }
    __syncthreads();
}
template <class TIn, class TOut>
__device__ __forceinline__ void causal_swa_block(const BlockRef<TIn, TOut>& cur, const BlockRef<TIn, TOut>& nxt, int skv, int W, char* lds, Seam<TIn>& S) {
    constexpr bool F32 = same_t<TIn, float>::v;
    const int tid = threadIdx.x, wid = __builtin_amdgcn_readfirstlane(tid >> 6), lane = tid & 63, r32 = lane & 31, hi = lane >> 5;
    const int j_lo = swa_jlo(cur.P0, W);
    int j_hi = (cur.P0 + QB - 1) / KVBLK + 1; if (j_hi > skv / KVBLK) j_hi = skv / KVBLK;
    const int NT = j_hi - j_lo;
    const int kbn = ((nxt.P0 + QB - 1) / KVBLK) * KVBLK;
    const int qlo = cur.P0 + wid * QBLK, qm = qlo + r32 - 4 * hi;
    char* V_lds = lds; char* K_lds = lds + 2 * SHM_V;
    float* ws = (float*)(lds + 2 * SHM_V + 2 * SHM_K) + wid * 64; float* li_l = ws, * al_l = ws + 32;
    float m_reg = -1e30f, l_reg = 0; f32x16 o[4] = {};
    const int sr = tid >> 4, sc = (tid & 15) * 8, vst0 = v_st(sr, sc), kws = KSWZ(sr, sc * 2); constexpr int vst1_d = 4 * 4 * 512;
    const int vb0 = (int)(uintptr_t)V_lds + v_rd_base(lane);
    const TIn* Kh = cur.K; const TIn* Vh = cur.V;
#define RESC(a) do { if (__any((a) < 1.f)) { if (hi == 0) al_l[r32] = (a); asm volatile("s_waitcnt lgkmcnt(0)" ::: "memory");              \
                     for (int d_ = 0; d_ < 4; ++d_) for (int r = 0; r < 16; ++r) o[d_][r] *= al_l[crow(r, hi)]; } } while (0)
#define KBASE(t) ((j_hi - 1 - (t)) * KVBLK)
#define ACT(t) (KBASE(t) <= qlo + QBLK - 1 && KBASE(t) + KVBLK - 1 >= qlo - W + 1)
#define MASKT(P0_, P1_, t) do { const int kb_ = KBASE(t); if ((!SK || ACT(t)) && (kb_ + KVBLK - 1 > qlo || kb_ <= qlo + QBLK - 1 - W)) mask_tile(P0_, P1_, qm - kb_, (unsigned)W); } while (0)
    constexpr int NQL = F32 ? 16 : 8;
    constexpr bool SK = WSKIP && !F32;
#define SEAM_K0() do { VMWN(NQL); if constexpr (F32) { SWRITE_KF(0); SBAR(); SLOAD_F((const float*)nxt.V, kbn); } else { SWRITE_HK(0); } SBAR(); } while (0)
    f32x16 pA0, pA1, pB0, pB1; float mnA, mnB, alA, alB; bf16x8 pa0, pa1, pa2, pa3;
    if constexpr (F32) { VMW(); SWRITE_VF(0); SBAR(); } else { SWRITE_HV(0); SBAR(); }
    if (NT > 1) { if constexpr (F32) SLOAD_F((const float*)Kh, KBASE(1)); else { SLOAD_H(Kh, Vh, KBASE(1)); SLOAD_B(cur.C, 0, KBASE(1)); } }
    SBAR(); qkt<0, SK>(pA0, pA1, K_lds, r32, hi, S.qr, ACT(0));
    if constexpr (F32) { if (NT > 1) { VMW(); SWRITE_KF(1); SBAR(); SLOAD_F((const float*)Vh, KBASE(1)); } }
    MASKT(pA0, pA1, 0); partialSM(pA0, pA1, m_reg, mnA, alA);
    if (NT > 1) { VMW(); if constexpr (F32) { SWRITE_VF(1); SBAR(); if (NT > 2) SLOAD_F((const float*)Kh, KBASE(2)); } else SWRITE_H(1); }
    __syncthreads();
#define HALF_STEP(PX0, PX1, mnX, alX, PY0, PY1, alY, t, KB, VB, SB) do {                                                      \
        SBAR(); qkt<KB, SK>(PX0, PX1, K_lds, r32, hi, S.qr, ACT(t));                                             \
        finishSM(PY0, PY1, alY, l_reg, pa0, pa1, pa2, pa3); SBAR();                                                           \
        if ((t) + 1 < NT) { if constexpr (F32) { VMW(); SWRITE_KF(SB); SBAR(); SLOAD_F((const float*)Vh, KBASE((t) + 1)); }  \
                            else { SLOAD_H(Kh, Vh, KBASE((t) + 1)); SLOAD_B(cur.C, 0, KBASE((t) + 1)); } SBAR(); }                                               \
        pv_tile<VB, SK>(o, vb0, pa0, pa1, pa2, pa3, ACT((t) - 1)); MASKT(PX0, PX1, (t)); partialSM(PX0, PX1, m_reg, mnX, alX);                                        \
        __syncthreads();                                                                                                      \
        if ((t) + 1 < NT) { VMW(); if constexpr (F32) { SWRITE_VF(SB); SBAR(); if ((t) + 2 < NT) SLOAD_F((const float*)Kh, KBASE((t) + 2)); } \
                            else { SWRITE_H(SB); } }                                                                          \
        RESC(alX); __syncthreads(); } while (0)
    for (int t = 1; t + 1 < NT; t += 2) {
        HALF_STEP(pB0, pB1, mnB, alB, pA0, pA1, alA, t, 1, 0, 0);
        HALF_STEP(pA0, pA1, mnA, alA, pB0, pB1, alB, t + 1, 0, 1, 1);
    }
    const bool even = (NT & 1) == 0;
    if (even) { SBAR(); qkt<1, SK>(pB0, pB1, K_lds, r32, hi, S.qr, ACT(NT - 1)); SBAR(); }
#define QROW(e) (nxt.Q + (size_t)(wid * QBLK + r32) * RS + ((e) >> 1) * 16 + hi * 8 + ((e) & 1) * 4)
    if constexpr (F32) { SLOAD_F((const float*)nxt.K, kbn); SBAR();
#pragma unroll
        for (int e = 0; e < 8; ++e) S.tq[e] = *(const f32x4*)QROW(e); }
    else { SLOAD_H(nxt.K, nxt.V, kbn); SLOAD_B(nxt.C, 0, kbn); SBAR();
#pragma unroll
        for (int d0 = 0; d0 < 8; ++d0) S.qr[d0] = load8<TIn>(nxt.Q + (size_t)(wid * QBLK + r32) * RS + d0 * 16 + hi * 8); }
    SBAR();
    finishSM(pA0, pA1, alA, l_reg, pa0, pa1, pa2, pa3); SBAR();
    if constexpr (F32) {
#pragma unroll
        for (int e = 8; e < 16; ++e) S.tq[e] = *(const f32x4*)QROW(e); SBAR(); }
#undef QROW
    pv_tile<0, SK>(o, vb0, pa0, pa1, pa2, pa3, ACT(even ? NT - 2 : NT - 1));
    if (even) { MASKT(pB0, pB1, NT - 1); partialSM(pB0, pB1, m_reg, mnB, alB); __syncthreads(); RESC(alB);
        finishSM(pB0, pB1, alB, l_reg, pa0, pa1, pa2, pa3); SBAR(); pv_tile<1, SK>(o, vb0, pa0, pa1, pa2, pa3, ACT(NT - 1)); }
    SBAR(); SEAM_K0();
    if (hi == 0) li_l[r32] = l_reg; asm volatile("s_waitcnt lgkmcnt(0)" ::: "memory");
    float rli[16];
#pragma unroll
    for (int r = 0; r < 16; ++r) rli[r] = __builtin_amdgcn_rcpf(li_l[crow(r, hi)]);
    int lnE = (int)threadIdx.x; asm volatile("" : "+v"(lnE)); const int r32E = lnE & 31, hiE = (lnE >> 5) & 1;
    TOut* Ow = cur.O + (size_t)(wid * QBLK) * RS;
#pragma unroll
    for (int r = 0; r < 16; ++r) { const int orow = crow(r, hiE);
#pragma unroll
        for (int d0 = 0; d0 < 4; ++d0) { const float v = o[d0][r] * rli[r];
            if constexpr (same_t<TOut, float>::v) { Ow[(size_t)orow * RS + d0 * 32 + r32E] = v; }
            else { const float vn = __shfl_xor(v, 1);
                   if ((r32E & 1) == 0) *(unsigned*)(Ow + (size_t)orow * RS + d0 * 32 + r32E) = cvtpk(v, vn); } } }
    if constexpr (F32) {
#pragma unroll
        for (int d0 = 0; d0 < 8; ++d0) S.qr[d0] = pack8(S.tq[2 * d0], S.tq[2 * d0 + 1]); }
    __syncthreads();
#undef RESC
#undef KBASE
#undef ACT
#undef MASKT
#undef SEAM_K0
#undef HALF_STEP
}
#undef ROW
#undef VMW
#undef VMWN
#undef SLOAD_H
#undef SLOAD_B
#undef SWRITE_B
#undef SWRITE_HK
#undef SWRITE_HV
#undef SWRITE_H
#undef SLOAD_F
#undef SWRITE_KF
#undef SWRITE_VF

#undef KSWZ
#undef SBAR
}

#ifndef MK_N_LAUNCHES
#define MK_N_LAUNCHES 1
#endif
#define LAS __attribute__((address_space(3)))
typedef unsigned short bf16_t;
typedef float f32x4 __attribute__((ext_vector_type(4)));
typedef unsigned u32x4 __attribute__((ext_vector_type(4)));
typedef unsigned u32x2 __attribute__((ext_vector_type(2)));
typedef short bf16x8 __attribute__((ext_vector_type(8)));

constexpr int DM = 1024, NB = 8, SEQ = 4096, NMETA = 16, LB = SEQ + NMETA, NH = 8, HD = 128, DFF = 2816, DIN = 8200;
constexpr int MMAIN = NB * SEQ, NROWS = NB * LB;
constexpr int NPROJ = 8192;
constexpr int CP = 4224;
constexpr float RMS_EPS = 1e-6f;
constexpr int NPHASE = 10;
constexpr int NWAVES = 8, NTHREADS = 512;
constexpr int LDS_BYTES = 139264;
constexpr int LDS_HALO = 131072;
constexpr int LDS_SROW = 136192;
constexpr int LDS_MISC = 135168;
constexpr size_t WS_PCNT = 16384;
constexpr size_t WS_CTL = 0, WS_SS = 65536, CTL_ZERO_BYTES = 65536 + 196608;

constexpr size_t MiB = 1u << 20;
constexpr size_t WS_LOGF = 1 * MiB, WS_C = 3 * MiB, WS_Z1M = 5 * MiB, WS_WO = 6 * MiB, WS_WFI = 8 * MiB, WS_WDN = 19 * MiB;
constexpr size_t WS_SLOT0 = 26 * MiB, SLOT = 65 * MiB;
constexpr size_t WS_Q = WS_SLOT0, WS_K = WS_SLOT0 + SLOT, WS_V = WS_SLOT0 + 2 * SLOT, WS_GB = WS_SLOT0 + 3 * SLOT, WS_CU = WS_SLOT0 + 4 * SLOT, WS_GA = WS_SLOT0 + 5 * SLOT, WS_GC = WS_SLOT0 + 6 * SLOT;
constexpr size_t WS_T = WS_Q, WS_MX = WS_K;
constexpr size_t WS_AHEAD = WS_SLOT0, WS_VHEAD = WS_SLOT0 + 3 * MiB, WS_ATAIL = WS_SLOT0 + 6 * MiB, WS_AMETA = WS_SLOT0 + 9 * MiB;
constexpr size_t WS_XB = WS_SLOT0 + 12 * MiB;
constexpr size_t WS_A = WS_SLOT0, WS_VAL = WS_SLOT0 + 178 * MiB, WS_H2 = WS_SLOT0 + 356 * MiB;
constexpr size_t WS_END = WS_SLOT0 + 7 * SLOT;
static_assert(WS_H2 + SLOT <= WS_END && (size_t)NROWS * DFF * 2 <= 178 * MiB && (size_t)(NROWS + 64) * DM * 2 <= SLOT, "ws map");
constexpr size_t DO_XN = 0, DO_WIN = 66 * MiB, DO_WA = 82 * MiB, DO_WC = 84 * MiB;
constexpr size_t DO_CUHEAD = 100 * MiB, DO_GBHEAD = 101 * MiB, DO_CUTAIL = 102 * MiB;

__device__ __forceinline__ unsigned cvtpk(float lo, float hi) { return pg8::cvt_pk_bf16(lo, hi); }
__device__ __forceinline__ float bf2f(bf16_t x) { return __uint_as_float((unsigned)x << 16); }
__device__ __forceinline__ void unpk8(const u32x4 w, float (&f)[8]) {
#pragma unroll
    for (int i = 0; i < 4; ++i) { f[2 * i] = __uint_as_float(w[i] << 16); f[2 * i + 1] = __uint_as_float(w[i] & 0xffff0000u); }
}
__device__ __forceinline__ float wave_sum(float v) {
#pragma unroll
    for (int o = 1; o < 64; o <<= 1) v += __shfl_xor(v, o);
    return v;
}
#define LDS_WAIT() asm volatile("s_waitcnt lgkmcnt(0)" ::: "memory")

__device__ __forceinline__ int win_conv_src(int n) {
    const int t = (n - 3072) >> 8, w = (n - 3072) & 255, bj = w >> 7, wc = (w >> 5) & 3, fq = (w >> 3) & 3, slot = (w >> 2) & 1, c = 64 * t + 16 * wc + 4 * fq;
    return (bj == 0 ? (slot == 0 ? 3080 : 4104) : (slot == 0 ? 5128 : 7176)) + c;
}
__device__ __forceinline__ void p0_transpose_item(const float* W, int ldw, int k0, int srccol0, bf16_t* WT, int K, int dstrow0, LAS float* scr, int lane, const float* kscale = nullptr, bool convmode = false) {
#pragma unroll
    for (int i = 0; i < 8; ++i) { const int kk = 8 * i + (lane >> 3), n4 = (lane & 7) * 4; f32x4 w = *(const f32x4*)(W + (size_t)(k0 + kk) * ldw + (convmode ? win_conv_src(dstrow0 + n4) : srccol0 + n4)); if (kscale) w = w * kscale[k0 + kk];
        scr[kk * 33 + n4] = w.x; scr[kk * 33 + n4 + 1] = w.y; scr[kk * 33 + n4 + 2] = w.z; scr[kk * 33 + n4 + 3] = w.w; }
    LDS_WAIT(); asm volatile("" ::: "memory");
    const int c = lane & 7;
#pragma unroll
    for (int j = 0; j < 4; ++j) { const int n = (lane >> 3) + 8 * j; const LAS float* s = scr + (8 * c) * 33 + n;
        u32x4 o; o.x = cvtpk(s[0 * 33], s[1 * 33]); o.y = cvtpk(s[2 * 33], s[3 * 33]); o.z = cvtpk(s[4 * 33], s[5 * 33]); o.w = cvtpk(s[6 * 33], s[7 * 33]);
        *(u32x4*)(WT + (size_t)(dstrow0 + n) * K + k0 + 8 * c) = o; }
    LDS_WAIT(); asm volatile("" ::: "memory");
}
__device__ __forceinline__ int win_src(int n0) {
    if (n0 < 3072) return n0;
    if (n0 < 4096) return 3080 + (n0 - 3072);
    if (n0 < 6144) { const int j = (n0 - 4096) >> 8, w = (n0 - 4096) & 255; return w < 128 ? 4104 + 128 * j + w : 5128 + 128 * j + (w - 128); }
    return 6152 + (n0 - 6144);
}
__device__ __forceinline__ int wfi_src(int n0) { const int j = n0 >> 8, w = n0 & 255; return w < 128 ? 128 * j + w : DFF + 128 * j + (w - 128); }

__device__ __forceinline__ void norm_row(const float* src, const float* g, bf16_t* dst, int lane, f32x4 (&y)[4]) {
    float ss = 0.f;
#pragma unroll
    for (int j = 0; j < 4; ++j) { y[j] = ((const f32x4*)src)[64 * j + lane]; ss += (y[j].x * y[j].x + y[j].y * y[j].y) + (y[j].z * y[j].z + y[j].w * y[j].w); }
    ss = wave_sum(ss);
    const float rstd = 1.0f / sqrtf(ss * (1.0f / DM) + RMS_EPS);
#pragma unroll
    for (int j = 0; j < 4; ++j) { const f32x4 gg = ((const f32x4*)g)[64 * j + lane]; y[j] = (y[j] * rstd) * gg;
        u32x2 o; o.x = cvtpk(y[j].x, y[j].y); o.y = cvtpk(y[j].z, y[j].w); *(u32x2*)(dst + 256 * j + 4 * lane) = o; }
}
__device__ __forceinline__ f32x4 mini_tile(const bf16_t* A, int lda, const bf16_t* Bt, int K, int n0, int lane) {
    const int fr = lane & 15, fq = lane >> 4; f32x4 acc = {0.f, 0.f, 0.f, 0.f};
    const bf16x8* ap = (const bf16x8*)(A + (size_t)fr * lda + fq * 8); const bf16x8* bp = (const bf16x8*)(Bt + (size_t)(n0 + fr) * K + fq * 8);
#pragma unroll 16
    for (int k = 0; k < K / 32; ++k) acc = __builtin_amdgcn_mfma_f32_16x16x32_bf16(bp[k * 4], ap[k * 4], acc, 0, 0, 0);
    return acc;
}
__device__ __forceinline__ void store4_allb(bf16_t* base, int fr, int col, const f32x4 v) {
    u32x2 o; o.x = cvtpk(v[0], v[1]); o.y = cvtpk(v[2], v[3]);
#pragma unroll
    for (int b = 0; b < NB; ++b) *(u32x2*)(base + (size_t)(b * LB + fr) * DM + col) = o;
}
__device__ __forceinline__ float sigm(float x) { return __builtin_amdgcn_rcpf(1.0f + __expf(-x)); }

#define XB_TMO      128
#define XB_XCNT(j)  (256  + 64 * (j))
#define XB_XSUB(j)  (1280 + 64 * (j))
#define XB_XGEN(j)  (2304 + 64 * (j))
#define XB_TOP      3328
#define XB_TOPGEN   3392
#define XCD_BAR_WORDS 3456
#define XB_SPIN_CAP (1u << 18)

__device__ __forceinline__ unsigned xb_ld(unsigned* p)              { return __hip_atomic_load(p, __ATOMIC_RELAXED, __HIP_MEMORY_SCOPE_AGENT); }
__device__ __forceinline__ unsigned xb_add(unsigned* p, unsigned v) { return __hip_atomic_fetch_add(p, v, __ATOMIC_RELAXED, __HIP_MEMORY_SCOPE_AGENT); }
__device__ __forceinline__ unsigned xb_xcc_id() { return (unsigned)__builtin_amdgcn_s_getreg((3 << 11) | 20) & 0xFu; }
#define XB_SPIN(cond, bar) do { unsigned _sp = 0; while (cond) { __builtin_amdgcn_s_sleep(1); \
    if ((++_sp & 255u) == 0u) { if (xb_ld(&(bar)[XB_TMO])) break; if (_sp > XB_SPIN_CAP) { atomicAdd(&(bar)[XB_TMO], 1u); break; } } } } while (0)

struct XcdBarrier {
    unsigned* bar; unsigned x;
    volatile LAS unsigned* st;
};

__device__ __forceinline__ XcdBarrier xcd_barrier_post(unsigned* bar, volatile LAS unsigned* st) {
    XcdBarrier b; b.bar = bar; b.x = xb_xcc_id(); b.st = st;
    if (threadIdx.x == 0) (void)xb_add(&bar[XB_XCNT(b.x)], 1u);
    return b;
}
__device__ __forceinline__ void xcd_barrier_complete(unsigned* bar, unsigned x, unsigned& nloc, unsigned& nx) {
    const unsigned G = gridDim.x * gridDim.y * gridDim.z;
    unsigned sum, cnt, mine, sp = 0u;
    for (;;) {
        sum = 0u; cnt = 0u; mine = 0u;
#pragma unroll
        for (unsigned j = 0; j < 16; ++j) { const unsigned c = xb_ld(&bar[XB_XCNT(j)]); sum += c; cnt += (c > 0u) ? 1u : 0u; mine = (j == x) ? c : mine; }
        if (sum == G) break;
        __builtin_amdgcn_s_sleep(1);
        if ((++sp & 255u) == 0u) { if (xb_ld(&bar[XB_TMO])) break; if (sp > XB_SPIN_CAP) { atomicAdd(&bar[XB_TMO], 1u); break; } }
    }
    nloc = mine > 0u ? mine : 1u; nx = cnt > 0u ? cnt : 1u;
}

__device__ __forceinline__ void xcd_barrier(const XcdBarrier& b) {
    asm volatile("s_waitcnt vmcnt(0)" ::: "memory");
    __syncthreads();
    if (threadIdx.x == 0) {
        unsigned* bar = b.bar;
        __builtin_amdgcn_s_waitcnt(0);
        unsigned nloc = b.st[0], nx = b.st[1];
        if (nloc == 0u) { xcd_barrier_complete(bar, b.x, nloc, nx); b.st[0] = nloc; b.st[1] = nx; }
        const unsigned old = xb_add(&bar[XB_XSUB(b.x)], 1u);
        const unsigned gen = old / nloc;
        if (old + 1u == (gen + 1u) * nloc) {
            __builtin_amdgcn_fence(__ATOMIC_RELEASE, "agent");
            asm volatile("s_waitcnt vmcnt(0)" ::: "memory");
            const unsigned og = xb_add(&bar[XB_TOP], 1u);
            const unsigned tg = og / nx;
            if (og + 1u == (tg + 1u) * nx) xb_add(&bar[XB_TOPGEN], 1u);
            else XB_SPIN(xb_ld(&bar[XB_TOPGEN]) == tg, bar);
            __builtin_amdgcn_fence(__ATOMIC_ACQUIRE, "agent");
            xb_add(&bar[XB_XGEN(b.x)], 1u);
            asm volatile("s_waitcnt vmcnt(0)" ::: "memory");
        } else {
            XB_SPIN(xb_ld(&bar[XB_XGEN(b.x)]) == gen, bar);
            __builtin_amdgcn_fence(__ATOMIC_ACQUIRE, "agent");
            asm volatile("s_waitcnt vmcnt(0)" ::: "memory");
        }
    }
    __syncthreads();
}

__device__ __forceinline__ att::BlockRef<att::bf16, att::bf16> att_ref(int it, int second, int nitems, const bf16_t* Qb, const bf16_t* Kb, const bf16_t* Vb, bf16_t* Ob, const float* CC) {
    if (it >= nitems) it = nitems - 1;
    const int bh = it >> 3, xx = it & 7, b = bh >> 3, h = bh & 7, qb = second ? 15 - xx : xx;
    att::BlockRef<att::bf16, att::bf16> r; const size_t rb = (size_t)b * LB;
    r.Q = (const att::bf16*)Qb + (rb + NMETA + (size_t)qb * 256) * DM + h * HD; r.O = (att::bf16*)Ob + (rb + NMETA + (size_t)qb * 256) * DM + h * HD;
    r.K = (const att::bf16*)Kb + rb * DM + h * HD; r.V = (const att::bf16*)Vb + rb * DM + h * HD; r.C = CC + (size_t)bh * CP; r.P0 = NMETA + qb * 256; return r;
}
struct Args { const float* in[14]; float* out; unsigned char* ws; int ph_lo, ph_hi; };

#define LOAD_PTRS() \
    const __attribute__((address_space(4))) Args* ap_ = (const __attribute__((address_space(4))) Args*)__builtin_amdgcn_kernarg_segment_ptr(); asm volatile("" : "+s"(ap_)); \
    int tid_ = (int)threadIdx.x; asm volatile("" : "+v"(tid_)); const int tid = tid_, lane = tid_ & 63; (void)tid; (void)lane; \
    const float* x = ap_->in[0]; const float* meta = ap_->in[1]; const float* g_mix = ap_->in[2]; const float* w_in = ap_->in[3]; const float* b_f = ap_->in[4]; \
    const float* conv_w = ap_->in[5]; const float* w_o_attn = ap_->in[6]; const float* w_o_conv = ap_->in[7]; const float* w_o = ap_->in[8]; const float* g_ffn = ap_->in[9]; \
    const float* w_ffn_in = ap_->in[10]; const float* ffn_conv_w = ap_->in[11]; const float* w_ffn_out = ap_->in[12]; const float* g_final = ap_->in[13]; \
    unsigned char* ws = ap_->ws; unsigned char* dob = (unsigned char*)ap_->out; float* out = ap_->out; \
    float* SS = (float*)(ws + WS_SS); float* AHEAD = (float*)(ws + WS_AHEAD); float* VHEAD = (float*)(ws + WS_VHEAD); float* ATAIL = (float*)(ws + WS_ATAIL); float* AMETA = (float*)(ws + WS_AMETA); float* LOGF = (float*)(ws + WS_LOGF); float* CC = (float*)(ws + WS_C); float* Z1M = (float*)(ws + WS_Z1M); \
    bf16_t* Wo_t = (bf16_t*)(ws + WS_WO); bf16_t* Wfi_t = (bf16_t*)(ws + WS_WFI); bf16_t* Wdn_t = (bf16_t*)(ws + WS_WDN); \
    bf16_t* Qb = (bf16_t*)(ws + WS_Q); bf16_t* Kb = (bf16_t*)(ws + WS_K); bf16_t* Vb = (bf16_t*)(ws + WS_V); bf16_t* GBb = (bf16_t*)(ws + WS_GB); bf16_t* CUb = (bf16_t*)(ws + WS_CU); \
    bf16_t* GAb = (bf16_t*)(ws + WS_GA); bf16_t* GCb = (bf16_t*)(ws + WS_GC); bf16_t* Tb = (bf16_t*)(ws + WS_T); bf16_t* MXb = (bf16_t*)(ws + WS_MX); \
    bf16_t* FAb = (bf16_t*)(ws + WS_A); bf16_t* FVb = (bf16_t*)(ws + WS_VAL); bf16_t* H2b = (bf16_t*)(ws + WS_H2); \
    bf16_t* XNb = (bf16_t*)(dob + DO_XN); bf16_t* Win_t = (bf16_t*)(dob + DO_WIN); bf16_t* Wa_t = (bf16_t*)(dob + DO_WA); bf16_t* Wc_t = (bf16_t*)(dob + DO_WC); \
    float* CUHEAD = (float*)(dob + DO_CUHEAD); float* GBHEAD = (float*)(dob + DO_GBHEAD); float* CUTAIL = (float*)(dob + DO_CUTAIL); bf16_t* Ob = XNb;
__global__ void __launch_bounds__(NTHREADS, 2) fwd_kernel(Args args) {
    extern __shared__ __attribute__((aligned(16))) unsigned char lds[];
    const int tid = threadIdx.x, lane = tid & 63, wave = __builtin_amdgcn_readfirstlane(tid >> 6);
    const int G = gridDim.x, bx = blockIdx.x;
    const int vcu = (G % 8 == 0) ? (bx % 8) * (G / 8) + bx / 8 : bx;
    const int gw = bx * NWAVES + wave, NGW = G * NWAVES;
    const int gwT = wave * G + bx;
    LAS unsigned char* glds = (LAS unsigned char*)lds;
    if (args.ph_lo < -5) cg::this_grid().sync();
    if (tid < 2) ((volatile LAS unsigned*)(lds + LDS_MISC))[tid] = 0u;
    __syncthreads();
    if (args.ph_hi - args.ph_lo > 1) (void)xcd_barrier_post((unsigned*)(args.ws + WS_CTL), (volatile LAS unsigned*)(lds + LDS_MISC));
    const int lo = args.ph_lo, hi = args.ph_hi;
#ifdef ONLY_PHASE
#define IN(k) ((k) == ONLY_PHASE && lo <= (k) && (k) < hi)
#else
#define IN(k) (lo <= (k) && (k) < hi)
#endif
#define SEAM(k) do { if (IN(k) && IN((k) + 1)) { XcdBarrier b_; b_.bar = (unsigned*)(((const __attribute__((address_space(4))) Args*)__builtin_amdgcn_kernarg_segment_ptr())->ws + WS_CTL); b_.x = xb_xcc_id(); b_.st = (volatile LAS unsigned*)(lds + LDS_MISC); xcd_barrier(b_); } } while (0)

    if (IN(0)) { LOAD_PTRS();
        LAS float* wfT = (LAS float*)(lds + 69632);
        for (int k = tid; k < DM; k += NTHREADS) { const f32x4 a = *(const f32x4*)(w_in + (size_t)k * DIN + 3072), b = *(const f32x4*)(w_in + (size_t)k * DIN + 3076);
            wfT[0 * DM + k] = a.x; wfT[1 * DM + k] = a.y; wfT[2 * DM + k] = a.z; wfT[3 * DM + k] = a.w; wfT[4 * DM + k] = b.x; wfT[5 * DM + k] = b.y; wfT[6 * DM + k] = b.z; wfT[7 * DM + k] = b.w; }
        __syncthreads();
#define P0_ROWSRC(rr) (((rr) - ((rr) / LB) * LB) < NMETA ? meta + (size_t)((rr) - ((rr) / LB) * LB) * DM : x + ((size_t)((rr) / LB) * SEQ + (((rr) - ((rr) / LB) * LB) - NMETA)) * DM)
        f32x4 nx[2][4];
#pragma unroll
        for (int u = 0; u < 2; ++u) { int rr = gw + u * NGW; if (rr >= NROWS) rr = gw; if (gw < NROWS) { const float* src = P0_ROWSRC(rr);
#pragma unroll
            for (int j = 0; j < 4; ++j) nx[u][j] = ((const f32x4*)src)[64 * j + lane]; } }
        for (int r = gw; r < NROWS; r += 2 * NGW) {
            int rr[2]; bool okr[2]; rr[0] = r; okr[0] = true; rr[1] = r + NGW; okr[1] = rr[1] < NROWS; if (!okr[1]) rr[1] = r;
            f32x4 y[2][4];
#pragma unroll
            for (int u = 0; u < 2; ++u)
#pragma unroll
                for (int j = 0; j < 4; ++j) y[u][j] = nx[u][j];
            if (r + 2 * NGW < NROWS) {
#pragma unroll
                for (int u = 0; u < 2; ++u) { int rn = r + (2 + u) * NGW; if (rn >= NROWS) rn = r + 2 * NGW; const float* src = P0_ROWSRC(rn);
#pragma unroll
                    for (int j = 0; j < 4; ++j) nx[u][j] = ((const f32x4*)src)[64 * j + lane]; } }
            float ss[2];
#pragma unroll
            for (int u = 0; u < 2; ++u) { ss[u] = 0.f;
#pragma unroll
                for (int j = 0; j < 4; ++j) ss[u] += (y[u][j].x * y[u][j].x + y[u][j].y * y[u][j].y) + (y[u][j].z * y[u][j].z + y[u][j].w * y[u][j].w); }
#pragma unroll
            for (int o = 1; o < 64; o <<= 1) { const float t0 = __shfl_xor(ss[0], o), t1 = __shfl_xor(ss[1], o); ss[0] += t0; ss[1] += t1; }
            float f[2][8];
#pragma unroll
            for (int u = 0; u < 2; ++u) { const float rstd = 1.0f / sqrtf(ss[u] * (1.0f / DM) + RMS_EPS); bf16_t* dst = XNb + (size_t)rr[u] * DM;
#pragma unroll
                for (int j = 0; j < 4; ++j) { const f32x4 gg = ((const f32x4*)g_mix)[64 * j + lane]; y[u][j] = (y[u][j] * rstd) * gg;
                    u32x2 o; o.x = cvtpk(y[u][j].x, y[u][j].y); o.y = cvtpk(y[u][j].z, y[u][j].w); if (okr[u]) *(u32x2*)(dst + 256 * j + 4 * lane) = o; }
#pragma unroll
                for (int h = 0; h < 8; ++h) { float s = 0.f;
#pragma unroll
                    for (int j = 0; j < 4; ++j) { const f32x4 w = *(const LAS f32x4*)(wfT + h * DM + 256 * j + 4 * lane); s += (y[u][j].x * w.x + y[u][j].y * w.y) + (y[u][j].z * w.z + y[u][j].w * w.w); }
                    f[u][h] = s; } }
            const bool b5 = lane & 32, b4 = lane & 16, b3 = lane & 8;
            float f4[2][4], f2[2][2], fv[2];
#pragma unroll
            for (int h = 0; h < 4; ++h)
#pragma unroll
                for (int u = 0; u < 2; ++u) { const float keep = b5 ? f[u][h + 4] : f[u][h], send = b5 ? f[u][h] : f[u][h + 4]; f4[u][h] = keep + __shfl_xor(send, 32); }
#pragma unroll
            for (int h = 0; h < 2; ++h)
#pragma unroll
                for (int u = 0; u < 2; ++u) { const float keep = b4 ? f4[u][h + 2] : f4[u][h], send = b4 ? f4[u][h] : f4[u][h + 2]; f2[u][h] = keep + __shfl_xor(send, 16); }
#pragma unroll
            for (int u = 0; u < 2; ++u) { const float keep = b3 ? f2[u][1] : f2[u][0], send = b3 ? f2[u][0] : f2[u][1]; fv[u] = keep + __shfl_xor(send, 8); }
#pragma unroll
            for (int o = 4; o >= 1; o >>= 1) { const float t0 = __shfl_xor(fv[0], o), t1 = __shfl_xor(fv[1], o); fv[0] += t0; fv[1] += t1; }
            if ((lane & 7) == 0) { const int h = lane >> 3; const float bf = b_f[h];
#pragma unroll
                for (int u = 0; u < 2; ++u) { const int b = rr[u] / LB, pos = rr[u] - b * LB; const float z = fv[u] + bf; const float lf = fminf(z, 0.f) - log1pf(expf(-fabsf(z))); if (okr[u]) LOGF[(size_t)(b * NH + h) * CP + pos] = lf; } }
        }
#undef P0_ROWSRC
        LAS float* scr = (LAS float*)(lds + wave * 8448);
        constexpr int I_IN = 16 * 256, I_SQ = 16 * 32, I_FI = 16 * 176, I_DN = 44 * 32, NITEMS = I_IN + 3 * I_SQ + I_FI + I_DN;
        for (int it = gw; it < NITEMS; it += NGW) {
            int r = it;
            if (r < I_IN) { const int kb = r >> 8, nb = r & 255, n0 = 32 * nb; const bool cv = n0 >= 3072 && n0 < 7168;
                p0_transpose_item(w_in, DIN, 64 * kb, n0 < 3072 ? n0 : 6152 + (n0 - 7168), Win_t, DM, n0, scr, lane, nullptr, cv); continue; } r -= I_IN;
            if (r < I_SQ) { p0_transpose_item(w_o_attn, DM, 64 * (r >> 5), 32 * (r & 31), Wa_t, DM, 32 * (r & 31), scr, lane); continue; } r -= I_SQ;
            if (r < I_SQ) { p0_transpose_item(w_o_conv, DM, 64 * (r >> 5), 32 * (r & 31), Wc_t, DM, 32 * (r & 31), scr, lane); continue; } r -= I_SQ;
            if (r < I_SQ) { p0_transpose_item(w_o, DM, 64 * (r >> 5), 32 * (r & 31), Wo_t, DM, 32 * (r & 31), scr, lane); continue; } r -= I_SQ;
            if (r < I_FI) { const int kb = r / 176, nb = r % 176; p0_transpose_item(w_ffn_in, 2 * DFF, 64 * kb, wfi_src(32 * nb), Wfi_t, DM, 32 * nb, scr, lane, g_ffn); continue; }     r -= I_FI;
            p0_transpose_item(w_ffn_out, DM, 64 * (r >> 5), 32 * (r & 31), Wdn_t, DFF, 32 * (r & 31), scr, lane);
        }
        __syncthreads();
    }
    SEAM(0);

    if (IN(1)) { LOAD_PTRS();
        if (gwT < NB * NH) {
            const float* src = LOGF + (size_t)gwT * CP; float* dst = CC + (size_t)gwT * CP;
            float vals[66];
#pragma unroll
            for (int i = 0; i < 66; ++i) { const int pos = 64 * i + lane; vals[i] = pos < LB ? src[pos] : 0.f; }
            double carry = 0.0;
#pragma unroll
            for (int i = 0; i < 66; ++i) { float v = vals[i];
#pragma unroll
                for (int o = 1; o < 64; o <<= 1) { const float t = __shfl_up(v, o); if (lane >= o) v += t; }
                dst[64 * i + lane] = (float)(-(carry + (double)v) * (double)att::INV_SCALE);     carry += (double)__shfl(v, 63); }
        }
        for (int j = gwT; j < NPROJ / 16; j += NGW) {
            const int n0 = 16 * j, fr = lane & 15, fq = lane >> 4;
            if (n0 < 3072) { const f32x4 v = mini_tile(XNb, DM, Win_t, DM, n0, lane); store4_allb(n0 < 1024 ? Qb : n0 < 2048 ? Kb : Vb, fr, (n0 & 1023) + 4 * fq, v); }
            else if (n0 < 7168) {
                const int t = (n0 - 3072) >> 8, w0 = (n0 - 3072) & 255;
                if (w0 < 128) { const f32x4 a = mini_tile(XNb, DM, Win_t, DM, n0, lane), b = mini_tile(XNb, DM, Win_t, DM, n0 + 128, lane);
                    const int ch = 64 * t + 16 * ((w0 >> 5) & 3) + 4 * (((w0 >> 3) & 3) + (fq >> 1)); f32x4 ub;
#pragma unroll
                    for (int e = 0; e < 4; ++e) ub[e] = __shfl(b[e], lane - 16);
                    if (fq & 1) { f32x4 gcv;
#pragma unroll
                        for (int e = 0; e < 4; ++e) gcv[e] = sigm(b[e]);
                        store4_allb(CUb, fr, ch, a * ub); store4_allb(GCb, fr, ch, gcv); }
                    else store4_allb(GBb, fr, ch, a); } }
            else { f32x4 v = mini_tile(XNb, DM, Win_t, DM, n0, lane);
#pragma unroll
                for (int e = 0; e < 4; ++e) v[e] = sigm(v[e]);
                store4_allb(GAb, fr, (n0 - 7168) + 4 * fq, v); }
        }
        pg8::Gemm g{XNb, Win_t, MMAIN, NPROJ, DM}; pg8::StaticOrder S; S.init(MMAIN, NPROJ, G, bx);
        pg8::EpiProj E{Qb, (size_t)(SLOT / 2), GBb, GAb, GCb, conv_w, CUHEAD, GBHEAD, CUTAIL, (LAS float*)(lds + LDS_HALO)};
        pg8::gemm_phase<pg8::EpiProj, pg8::StaticOrder, true, true>(glds, g, S, E);
    }
    SEAM(1);

    if (IN(2)) { LOAD_PTRS();
        {
            typedef att::BlockRef<att::bf16, att::bf16> BR;
            const int nitems = NB * NH * 8, per = (nitems + G - 1) / G;
            att::Seam<att::bf16> S;
#define mk(k) att_ref(vcu * per + ((k) >> 1), (k) & 1, nitems, Qb, Kb, Vb, Ob, CC)
            int nblk = 2 * per; { const int first = vcu * per; if (first >= nitems) nblk = 0; else if (first + per > nitems) nblk = 2 * (nitems - first); }
#ifndef NO_ATT
            if (nblk > 0) {
                BR cur = mk(0);
                att::causal_swa_prime<att::bf16, att::bf16>(cur, 1 << 24, (char*)lds, S);
                for (int k = 0; k < nblk; ++k) { const BR nxt = (k + 1 < nblk) ? mk(k + 1) : cur;
                    att::causal_swa_block<att::bf16, att::bf16>(cur, nxt, 4160, 1 << 24, (char*)lds, S); cur = nxt; }
            }
#endif
#undef mk
            __syncthreads();
        }
        for (int job = gwT; job < NH * NMETA; job += NGW) {
            const int h = job >> 4, i = job & 15, jk = lane & 15, part = lane >> 4; const float* c = CC + (size_t)h * CP;
            float dsum = 0.f;
            { const bf16_t* qp = Qb + (size_t)i * DM + h * HD + part * 32; const bf16_t* kp = Kb + (size_t)jk * DM + h * HD + part * 32;
#pragma unroll
              for (int d8 = 0; d8 < 4; ++d8) { float tq[8], tk[8]; unpk8(*(const u32x4*)(qp + 8 * d8), tq); unpk8(*(const u32x4*)(kp + 8 * d8), tk);
#pragma unroll
                  for (int e = 0; e < 8; ++e) dsum += tq[e] * tk[e]; } }
            dsum += __shfl_xor(dsum, 16); dsum += __shfl_xor(dsum, 32);
            const bool ok = jk <= i; const float sj = ok ? (dsum + (c[jk] - c[i])) * att::SCALE : -1e30f;
            float mx = sj;
#pragma unroll
            for (int o = 1; o < 16; o <<= 1) mx = fmaxf(mx, __shfl_xor(mx, o));
            float p = ok ? __expf(sj - mx) : 0.f, l = p;
#pragma unroll
            for (int o = 1; o < 16; o <<= 1) l += __shfl_xor(l, o);
            p *= 1.0f / l;
            float o0 = 0.f, o1 = 0.f;
#pragma unroll
            for (int jj = 0; jj < 16; ++jj) { const float pj = __shfl(p, jj); const unsigned vv = *(const unsigned*)(Vb + (size_t)jj * DM + h * HD + 2 * lane);
                o0 += pj * __uint_as_float(vv << 16); o1 += pj * __uint_as_float(vv & 0xffff0000u); }
            *(unsigned*)(Ob + (size_t)i * DM + h * HD + 2 * lane) = cvtpk(o0, o1);
        }
        {
            const int ntask = 128; int tid2 = (int)threadIdx.x; asm volatile("" : "+v"(tid2));
            if (bx == 0) for (int task = tid2; task < ntask; task += NTHREADS) {
                const int cc = task & 127, rc = task >> 7, pos0 = (rc % 257) * 16, col = cc * 8; const size_t r0 = (size_t)rc * 16;
                float w0[8], w1[8], w2[8];
#pragma unroll
                for (int e = 0; e < 8; ++e) { w0[e] = conv_w[col + e]; w1[e] = conv_w[DM + col + e]; w2[e] = conv_w[2 * DM + col + e]; }
                float p2[8], p1[8];
                if (pos0) { unpk8(*(const u32x4*)(CUb + (r0 - 2) * DM + col), p2); unpk8(*(const u32x4*)(CUb + (r0 - 1) * DM + col), p1); }
                else {
#pragma unroll
                    for (int e = 0; e < 8; ++e) { p2[e] = 0.f; p1[e] = 0.f; } }
#pragma unroll 4
                for (int i = 0; i < 16; ++i) { float cu[8], gb[8]; unpk8(*(const u32x4*)(CUb + (r0 + i) * DM + col), cu); unpk8(*(const u32x4*)(GBb + (r0 + i) * DM + col), gb);
                    float y[8];
#pragma unroll
                    for (int e = 0; e < 8; ++e) { y[e] = gb[e] * (w0[e] * p2[e] + w1[e] * p1[e] + w2[e] * cu[e]); p2[e] = p1[e]; p1[e] = cu[e]; }
                    u32x4 o; o.x = cvtpk(y[0], y[1]); o.y = cvtpk(y[2], y[3]); o.z = cvtpk(y[4], y[5]); o.w = cvtpk(y[6], y[7]); *(u32x4*)(GBb + (r0 + i) * DM + col) = o; }
            }
        }
    }
    SEAM(2);

    if (IN(3)) { LOAD_PTRS();
        for (int j = gwT; j < DM / 16; j += NGW) {
            const int n0 = 16 * j, fr = lane & 15, fq = lane >> 4, col = n0 + 4 * fq;
            const f32x4 ya = mini_tile(Ob, DM, Wa_t, DM, n0, lane), yc = mini_tile(GBb, DM, Wc_t, DM, n0, lane);
            const u32x2 ga = *(const u32x2*)(GAb + (size_t)fr * DM + col), gc = *(const u32x2*)(GCb + (size_t)fr * DM + col);
            f32x4 m;
            m[0] = __uint_as_float(ga.x << 16) * ya[0] + __uint_as_float(gc.x << 16) * yc[0]; m[1] = __uint_as_float(ga.x & 0xffff0000u) * ya[1] + __uint_as_float(gc.x & 0xffff0000u) * yc[1];
            m[2] = __uint_as_float(ga.y << 16) * ya[2] + __uint_as_float(gc.y << 16) * yc[2]; m[3] = __uint_as_float(ga.y & 0xffff0000u) * ya[3] + __uint_as_float(gc.y & 0xffff0000u) * yc[3];
            u32x2 o; o.x = cvtpk(m[0], m[1]); o.y = cvtpk(m[2], m[3]); *(u32x2*)(MXb + (size_t)fr * DM + col) = o;
        }
        {
            pg8::StaticOrder S0; S0.init(MMAIN, DM, G, bx); pg8::Unit uu;
            for (int i = 0; S0.next(i, uu); ++i) { const int pm = uu.pm;
                for (int c = tid; c < DM; c += NTHREADS) { float cm2, cm1;
                    if (pm & 15) { cm2 = CUTAIL[(size_t)(pm - 1) * 2 * DM + c]; cm1 = CUTAIL[((size_t)(pm - 1) * 2 + 1) * DM + c]; }
                    else { const size_t mr = (size_t)(pm >> 4) * LB; cm2 = bf2f(CUb[(mr + 14) * DM + c]); cm1 = bf2f(CUb[(mr + 15) * DM + c]); }
                    const float c0 = CUHEAD[(size_t)pm * 2 * DM + c], c1 = CUHEAD[((size_t)pm * 2 + 1) * DM + c], w0 = conv_w[c], w1 = conv_w[DM + c], w2 = conv_w[2 * DM + c];
                    const float y0 = GBHEAD[(size_t)pm * 2 * DM + c] * (w0 * cm2 + w1 * cm1 + w2 * c0), y1 = GBHEAD[((size_t)pm * 2 + 1) * DM + c] * (w0 * cm1 + w1 * c0 + w2 * c1);
                    bf16_t* yp = GBb + (size_t)pg8::arow(pm) * DM + c; yp[0] = (bf16_t)(cvtpk(y0, 0.f) & 0xffffu); yp[DM] = (bf16_t)(cvtpk(y1, 0.f) & 0xffffu); } }
            asm volatile("s_waitcnt vmcnt(0)" ::: "memory"); __syncthreads();
        }
        { pg8::Gemm g{Ob, Wa_t, MMAIN, DM, DM}; g.nt2 = DM / 64; g.dA = (long)((const char*)GBb - (const char*)Ob); g.dB = (long)((const char*)Wc_t - (const char*)Wa_t);
          pg8::StaticOrder S; S.init(MMAIN, DM, G, bx); pg8::EpiGate2 E{GAb, GCb, MXb};
          pg8::gemm_phase<pg8::EpiGate2, pg8::StaticOrder, true, true>(glds, g, S, E); }
    }
    SEAM(3);

    if (IN(4)) { LOAD_PTRS();
        for (int j = gwT; j < DM / 16; j += NGW) {
            const int n0 = 16 * j, fr = lane & 15, fq = lane >> 4, col = n0 + 4 * fq;
            const f32x4 v = *(const f32x4*)(meta + (size_t)fr * DM + col) + mini_tile(MXb, DM, Wo_t, DM, n0, lane);
            u32x2 o; o.x = cvtpk(v[0], v[1]); o.y = cvtpk(v[2], v[3]); *(u32x2*)(H2b + (size_t)fr * DM + col) = o;
            float s = (v[0] * v[0] + v[1] * v[1]) + (v[2] * v[2] + v[3] * v[3]); s += __shfl_xor(s, 16); s += __shfl_xor(s, 32);
            if (fq == 0) atomicAdd(SS + MMAIN + fr, s);
        }
        pg8::Gemm g{MXb, Wo_t, MMAIN, DM, DM}; pg8::StaticOrder S; S.init(MMAIN, DM, G, bx); pg8::EpiResSS E{x, out, H2b, SS};
        pg8::gemm_phase<pg8::EpiResSS, pg8::StaticOrder, true, true>(glds, g, S, E);
    }
    SEAM(4);


    if (IN(6)) { LOAD_PTRS();
        for (int j = gwT; j < DFF / 16; j += NGW) {
            const int c0 = 16 * j, fr = lane & 15, fq = lane >> 4;
            const float rs = 1.0f / sqrtf(SS[MMAIN + fr] * (1.0f / DM) + RMS_EPS);
            const f32x4 v = mini_tile(H2b, DM, Wfi_t, DM, 256 * (c0 >> 7) + (c0 & 127), lane) * rs;
            *(f32x4*)(AMETA + (size_t)fr * DFF + c0 + 4 * fq) = v;
        }
        pg8::Gemm g{H2b, Wfi_t, MMAIN, 2 * DFF, DM}; pg8::StaticOrder S; S.init(MMAIN, 2 * DFF, G, bx); pg8::EpiFfnConv E{FVb, SS, ffn_conv_w, AHEAD, VHEAD, ATAIL, (LAS float*)(lds + LDS_HALO)};
        pg8::gemm_phase<pg8::EpiFfnConv, pg8::StaticOrder, true, true>(glds, g, S, E);
    }
    SEAM(6);


    if (IN(8)) { LOAD_PTRS();
        pg8::Gemm g{FVb, Wdn_t, MMAIN, DM, DFF}; pg8::StaticOrder S; S.init(MMAIN, DM, G, bx); pg8::EpiResNorm E{H2b, out, g_final, (float*)(ws + WS_XB), (unsigned*)(ws + WS_PCNT), (LAS float*)(lds + LDS_HALO), (LAS float*)(lds + LDS_SROW)};
        {
            pg8::Unit uu;
            for (int i = 0; S.next(i, uu); ++i) { const int pm = uu.pm; const float* pa = (pm & 15) ? ATAIL + (size_t)(pm - 1) * 2 * DFF : AMETA + (size_t)14 * DFF;
                for (int c = tid; c < DFF; c += NTHREADS) { const float am2 = pa[c], am1 = pa[DFF + c], a0 = AHEAD[(size_t)pm * 2 * DFF + c], a1 = AHEAD[((size_t)pm * 2 + 1) * DFF + c];
                    const float w0 = ffn_conv_w[c], w1 = ffn_conv_w[DFF + c], w2 = ffn_conv_w[2 * DFF + c];
                    const float c0 = w0 * am2 + w1 * am1 + w2 * a0, c1 = w0 * am1 + w1 * a0 + w2 * a1;
                    const float s0 = c0 * sigm(c0) * VHEAD[(size_t)pm * 2 * DFF + c], s1 = c1 * sigm(c1) * VHEAD[((size_t)pm * 2 + 1) * DFF + c];
                    bf16_t* sp = FVb + (size_t)pg8::arow(pm) * DFF + c; sp[0] = (bf16_t)(cvtpk(s0, 0.f) & 0xffffu); sp[DFF] = (bf16_t)(cvtpk(s1, 0.f) & 0xffffu); } }
            asm volatile("s_waitcnt vmcnt(0)" ::: "memory"); __syncthreads();
        }
        pg8::gemm_phase<pg8::EpiResNorm, pg8::StaticOrder, true, true>(glds, g, S, E);
    }


#ifdef DUMP_AFTER
    if (lo == 100) { LOAD_PTRS();
        for (size_t i = (size_t)bx * NTHREADS + tid; i < (size_t)MMAIN * DM; i += (size_t)G * NTHREADS) {
            const int r = (int)(i >> 10), c = (int)(i & 1023); const size_t sr = (size_t)(r >> 12) * LB + NMETA + (r & 4095); const size_t mr = (size_t)((r >> 4) & 7) * LB + (r & 15);
            float v = 0.f;
#if DUMP_AFTER == 0
            v = bf2f(XNb[sr * DM + c]) + 3.f * bf2f(XNb[mr * DM + c]) + bf2f(Win_t[((size_t)r % 8192) * DM + c]) + bf2f(Wa_t[((size_t)r & 1023) * DM + c]) + bf2f(Wc_t[((size_t)r & 1023) * DM + c]) + bf2f(Wo_t[((size_t)r & 1023) * DM + c]) + bf2f(Wfi_t[((size_t)r % 5632) * DM + c]) + bf2f(Wdn_t[((size_t)(r & 1023)) * DFF + c]) + bf2f(Wdn_t[((size_t)(r & 1023)) * DFF + 1792 + c]) + LOGF[(size_t)(r & 63) * CP + (c + 1024 * ((r >> 6) & 3)) % LB];
#elif DUMP_AFTER == 1
            v = bf2f(Qb[sr * DM + c]) + 2.f * bf2f(Kb[sr * DM + c]) + 3.f * bf2f(Vb[sr * DM + c]) + 5.f * bf2f(GBb[sr * DM + c]) + 7.f * bf2f(CUb[sr * DM + c]) + 11.f * bf2f(GAb[sr * DM + c]) + 13.f * bf2f(GCb[sr * DM + c])
              + bf2f(Qb[mr * DM + c]) + 2.f * bf2f(Kb[mr * DM + c]) + 3.f * bf2f(Vb[mr * DM + c]) + 5.f * bf2f(GBb[mr * DM + c]) + 7.f * bf2f(CUb[mr * DM + c]) + 11.f * bf2f(GAb[mr * DM + c]) + 13.f * bf2f(GCb[mr * DM + c]) + 1e-3f * CC[(size_t)(r & 63) * CP + (c + 1024 * ((r >> 6) & 3))];
#elif DUMP_AFTER == 11
            v = 11.f * bf2f(GAb[sr * DM + c]) + 13.f * bf2f(GCb[sr * DM + c]);
#elif DUMP_AFTER == 12
            v = bf2f(Qb[sr * DM + c]) + 2.f * bf2f(Kb[sr * DM + c]) + 3.f * bf2f(Vb[sr * DM + c]) + 5.f * bf2f(GBb[sr * DM + c]) + 7.f * bf2f(CUb[sr * DM + c]);
#elif DUMP_AFTER == 13
            v = bf2f(Qb[mr * DM + c]) + 2.f * bf2f(Kb[mr * DM + c]) + 3.f * bf2f(Vb[mr * DM + c]) + 5.f * bf2f(GBb[mr * DM + c]) + 7.f * bf2f(CUb[mr * DM + c]) + 11.f * bf2f(GAb[mr * DM + c]) + 13.f * bf2f(GCb[mr * DM + c]);
#elif DUMP_AFTER == 14
            v = CC[(size_t)(r & 63) * CP + (c + 1024 * ((r >> 6) & 3))];
#elif DUMP_AFTER == 2
            v = bf2f(Ob[sr * DM + c]) + 3.f * bf2f(GBb[sr * DM + c]) + bf2f(Ob[(size_t)(r & 15) * DM + c]) + bf2f(GBb[mr * DM + c]);
#elif DUMP_AFTER == 3
            v = bf2f(MXb[sr * DM + c]) + bf2f(MXb[(size_t)(r & 15) * DM + c]);
#elif DUMP_AFTER == 5
            v = bf2f(H2b[sr * DM + c]) + bf2f(H2b[(size_t)(r & 15) * DM + c]);
#elif DUMP_AFTER == 6
            v = bf2f(FAb[sr * DFF + c]) + bf2f(FAb[sr * DFF + 1792 + c]) + 3.f * bf2f(FVb[sr * DFF + c]) + 3.f * bf2f(FVb[sr * DFF + 1792 + c]) + bf2f(FAb[mr * DFF + c]) + bf2f(FAb[mr * DFF + 1792 + c]);
#elif DUMP_AFTER == 7
            v = bf2f(FVb[sr * DFF + c]) + bf2f(FVb[sr * DFF + 1792 + c]);
#endif
#if DUMP_AFTER == 0 || DUMP_AFTER == 2
            ((float*)(ws + WS_Q))[i] = v; }
#else
            out[i] = v; }
#endif
    }
    if (lo == 101) { LOAD_PTRS(); for (size_t i = (size_t)bx * NTHREADS + tid; i < (size_t)MMAIN * DM; i += (size_t)G * NTHREADS) out[i] = ((const float*)(ws + WS_Q))[i]; }
#endif
#undef IN
#undef SEAM
}

extern "C" void kernel_launch(void* const* d_in, const int* in_sizes, int n_in, void* d_out, int out_size, void* d_ws, size_t ws_size, hipStream_t stream) {
    static int grid = 0;
    if (grid == 0) {
        if (n_in != 14 || in_sizes[0] != MMAIN * DM || out_size != MMAIN * DM || ws_size < WS_END) {
            fprintf(stderr, "kernel_launch: unexpected shapes (n_in %d, in0 %d, out %d, ws %zu; need ws >= %zu)\n", n_in, n_in > 0 ? in_sizes[0] : -1, out_size, ws_size, (size_t)WS_END); grid = -1; return; }
        int dev = 0, cus = 0, per_cu = 0;
        (void)hipGetDevice(&dev); (void)hipDeviceGetAttribute(&cus, hipDeviceAttributeMultiprocessorCount, dev);
        if (hipFuncSetAttribute((const void*)fwd_kernel, hipFuncAttributeMaxDynamicSharedMemorySize, LDS_BYTES) != hipSuccess) { fprintf(stderr, "kernel_launch: hipFuncSetAttribute failed\n"); grid = -1; return; }
        if (hipOccupancyMaxActiveBlocksPerMultiprocessor(&per_cu, (const void*)fwd_kernel, NTHREADS, LDS_BYTES) != hipSuccess || per_cu < 1) { fprintf(stderr, "kernel_launch: occupancy query says %d blocks per CU\n", per_cu); per_cu = 1; (void)hipGetLastError(); }
        if (cus <= 0) cus = 256;
        grid = cus;
    }
    if (grid < 0) return;
    if (hipMemsetAsync((char*)d_ws + WS_CTL, 0, CTL_ZERO_BYTES, stream) != hipSuccess) { fprintf(stderr, "kernel_launch: hipMemsetAsync failed\n"); return; }
    Args a{};
    for (int i = 0; i < 14; ++i) a.in[i] = (const float*)d_in[i];
    a.out = (float*)d_out; a.ws = (unsigned char*)d_ws;
#if MK_N_LAUNCHES == 1
    a.ph_lo = 0; a.ph_hi = NPHASE;
    void* kargs[] = {&a};
    hipError_t e = hipLaunchCooperativeKernel((const void*)fwd_kernel, dim3(grid), dim3(NTHREADS), kargs, LDS_BYTES, stream);
    if (e != hipSuccess) fprintf(stderr, "kernel_launch: cooperative launch failed: %s (grid %d)\n", hipGetErrorString(e), grid);
#else
#ifdef DUMP_AFTER
    const int np_ = (DUMP_AFTER >= 11 ? 1 : DUMP_AFTER) + 1;
#else
    const int np_ = NPHASE;
#endif
    for (int p = 0; p <= np_; ++p) { if (p == np_) {
#if defined(DUMP_AFTER) && DUMP_AFTER != 4 && DUMP_AFTER != 8
            a.ph_lo = 100; a.ph_hi = 101;
#if DUMP_AFTER == 0 || DUMP_AFTER == 2
            hipLaunchKernelGGL(fwd_kernel, dim3(grid), dim3(NTHREADS), LDS_BYTES, stream, a); a.ph_lo = 101; a.ph_hi = 102;
#endif
#else
            break;
#endif
        } else { a.ph_lo = p; a.ph_hi = p + 1; }
        hipLaunchKernelGGL(fwd_kernel, dim3(grid), dim3(NTHREADS), LDS_BYTES, stream, a);
        if (hipPeekAtLastError() != hipSuccess) { fprintf(stderr, "kernel_launch: launch %d failed\n", p); break; } }
#endif
}
```

```cpp
#include <hip/hip_runtime.h>
#include <hip/hip_cooperative_groups.h>
#include <hip/hip_bf16.h>
#include <cstdio>
#include <cstdint>
#include <cmath>
namespace cg = cooperative_groups;
namespace pg8 {
#define PG8_LAS __attribute__((address_space(3)))
typedef unsigned short bf16_t;
typedef short bf16x8 __attribute__((ext_vector_type(8)));
typedef float f32x4 __attribute__((ext_vector_type(4)));
typedef unsigned u32x4 __attribute__((ext_vector_type(4)));
constexpr int BM = 256, BK = 64, HALF = 128, HTB = HALF * BK * 2  , STAGE_BYTES = 8 * HTB, NXCD = 8, WGM = 8;

__host__ __device__ __forceinline__ int lds_byte(int r, int c) { const int st = (r >> 4) * 2 + (c >> 5), rr = r & 15, cc = c & 31, ob = rr * 64 + cc * 2; return st * 1024 + (ob ^ (((ob >> 9) & 1) << 5)); }
__host__ __device__ __forceinline__ void stage_rc(int b, int& R, int& C) { const int st = b / 1024, sb = b % 1024, swz = sb ^ (((sb >> 9) & 1) << 5); R = (st >> 1) * 16 + swz / 64; C = (st & 1) * 32 + (swz % 64) / 2; }
__host__ __device__ __forceinline__ int perm32(int rho) { const int n = rho >> 4, i = rho & 15; return 8 * (i >> 2) + 4 * n + (i & 3); }

__host__ __device__ __forceinline__ int arow(int pm) { return (pm >> 4) * 4112 + 16 + (pm & 15) * 256; }
struct Unit { int pm, pn; };
struct Gemm { const bf16_t* A; const bf16_t* Bt; int M, N, K; int nt2 = 0; long dA = 0, dB = 0; };

struct StaticOrder {
    int nM, nN, nwg, G, c;
    __host__ __device__ void init(int M, int N, int G_, int c_) { nM = M / BM; nN = N / BM; nwg = nM * nN; G = G_; c = c_; }
    __host__ __device__ bool next(int i, Unit& u) const {
        const long L = (long)i * G + c; if (L >= nwg) return false;
        int wgid = (int)L; { const int q = nwg / NXCD, r = nwg % NXCD, xcd = wgid % NXCD, off = wgid / NXCD; wgid = (xcd < r ? xcd * (q + 1) : r * (q + 1) + (xcd - r) * q) + off; }
        const int nig = WGM * nN, gid = wgid / nig, fm = gid * WGM, gsz = (nM - fm) < WGM ? (nM - fm) : WGM;
        u.pm = fm + ((wgid % nig) % gsz); u.pn = (wgid % nig) / gsz; return true;
    }
    __device__ __forceinline__ void a_ready(const Unit&) const {}
    __device__ __forceinline__ void done(const Unit&) const {}
};

typedef float f32x2c_t __attribute__((ext_vector_type(2))); typedef __bf16 bf16x2c_t __attribute__((ext_vector_type(2)));
__device__ __forceinline__ unsigned cvt_pk_bf16(float lo, float hi) { f32x2c_t v = {lo, hi}; return __builtin_bit_cast(unsigned, __builtin_convertvector(v, bf16x2c_t)); }
typedef float f32x2 __attribute__((ext_vector_type(2)));
template <class Epi, class Sched, bool ALIGN_EPI = false, bool SP2 = false>
__device__ __forceinline__ void gemm_phase(PG8_LAS unsigned char* lds, const Gemm g, const Sched& S, const Epi& E) {
    const int tid = threadIdx.x, wid = __builtin_amdgcn_readfirstlane(tid >> 6), lane = tid & 63, wr = wid >> 2, wc = wid & 3, fr = lane & 15, fq = lane >> 4;
    const int K = g.K, nt1 = K / BK, nt = Epi::HAS_MID ? nt1 + g.nt2 : nt1;
    unsigned voffA[2], voffB[2];
#pragma unroll
    for (int i = 0; i < 2; ++i) { int R, C; stage_rc(tid * 16 + i * 8192, R, C); const int Rb = Epi::PERM ? ((R & ~31) + perm32(R & 31)) : R;
        voffA[i] = (unsigned)(R * K + C) * 2u; voffB[i] = (unsigned)(Rb * K + C) * 2u; }
    const size_t kstep = (size_t)(BK * 2);
    const size_t hstep = (size_t)HALF * K * 2;
    const size_t tstep = 2 * hstep;
    const unsigned ldsw = (unsigned)wid * 1024u;
    const int aoff = lds_byte(wr * 64 + fr, fq * 8), boff = lds_byte(wc * 32 + fr, fq * 8);
#define PG8_SA(b, h) (((b) * 2 + (h)) * HTB)
#define PG8_SB(b, h) ((4 + (b) * 2 + (h)) * HTB)
#define PG8_STAGE(bufoff, gbase, voff) do { _Pragma("unroll") for (int _i = 0; _i < 2; ++_i) \
        __builtin_amdgcn_global_load_lds((const unsigned*)((const char*)(gbase) + (voff)[_i]), (PG8_LAS unsigned*)(lds + (bufoff) + ldsw + _i * 8192), 16, 0, 0); } while (0)
#define PG8_LDA(dst, b, h) do { _Pragma("unroll") for (int m = 0; m < 4; ++m) _Pragma("unroll") for (int k = 0; k < 2; ++k) dst[m][k] = *(const PG8_LAS bf16x8*)(lds + PG8_SA(b, h) + aoff + m * 2048 + k * 1024); } while (0)
#define PG8_LDB(dst, b, h) do { _Pragma("unroll") for (int n = 0; n < 2; ++n) _Pragma("unroll") for (int k = 0; k < 2; ++k) dst[n][k] = *(const PG8_LAS bf16x8*)(lds + PG8_SB(b, h) + boff + n * 2048 + k * 1024); } while (0)
#define PG8_MMA(ai, bj, At, Bt) do { __builtin_amdgcn_s_setprio(1); _Pragma("unroll") for (int m = 0; m < 4; ++m) _Pragma("unroll") for (int n = 0; n < 2; ++n) _Pragma("unroll") for (int k = 0; k < 2; ++k) \
        acc[ai][bj][m][n] = __builtin_amdgcn_mfma_f32_16x16x32_bf16(Bt[n][k], At[m][k], acc[ai][bj][m][n], 0, 0, 0); __builtin_amdgcn_s_setprio(0); } while (0)
#define PG8_WAIT_V(n) asm volatile("s_waitcnt vmcnt(" #n ")" ::: "memory")
#define PG8_WAIT_L(n) asm volatile("s_waitcnt lgkmcnt(" #n ")" ::: "memory")
#define PG8_BAR __builtin_amdgcn_s_barrier()
#define PG8_SCHED __builtin_amdgcn_sched_barrier(0)
    Unit cur, nxt; int ui = 0;
    if (!S.next(0, cur)) return;
    f32x4 acc[2][2][4][2];
#pragma unroll
    for (int a = 0; a < 2; ++a)
#pragma unroll
        for (int b = 0; b < 2; ++b)
#pragma unroll
            for (int m = 0; m < 4; ++m)
#pragma unroll
                for (int n = 0; n < 2; ++n) acc[a][b][m][n] = (f32x4){0.f, 0.f, 0.f, 0.f};
    bf16x8 At[4][2], B0[2][2], B1[2][2];
    const char* cA = (const char*)g.A + (size_t)arow(cur.pm) * (size_t)K * 2; const char* cB = (const char*)g.Bt + (size_t)cur.pn * tstep;
    S.a_ready(cur);
    if constexpr (SP2) {
        PG8_STAGE(PG8_SB(0, 0), cB, voffB); PG8_STAGE(PG8_SB(0, 1), cB + hstep, voffB); PG8_STAGE(PG8_SA(0, 0), cA, voffA); PG8_STAGE(PG8_SA(0, 1), cA + hstep, voffA);
        if (wr == 1) PG8_BAR;
        PG8_WAIT_V(2); PG8_BAR;
        PG8_STAGE(PG8_SB(1, 0), cB + kstep, voffB); PG8_STAGE(PG8_SA(1, 0), cA + kstep, voffA); PG8_STAGE(PG8_SB(1, 1), cB + hstep + kstep, voffB);
        PG8_WAIT_V(6); PG8_BAR;
    } else {
        PG8_STAGE(PG8_SB(0, 0), cB, voffB); PG8_STAGE(PG8_SA(0, 0), cA, voffA); PG8_STAGE(PG8_SB(0, 1), cB + hstep, voffB); PG8_STAGE(PG8_SA(0, 1), cA + hstep, voffA);
        if (wr == 1) PG8_BAR;
        PG8_WAIT_V(4); PG8_BAR;
        PG8_STAGE(PG8_SB(1, 0), cB + kstep, voffB); PG8_STAGE(PG8_SA(1, 0), cA + kstep, voffA); PG8_STAGE(PG8_SB(1, 1), cB + hstep + kstep, voffB);
        PG8_WAIT_V(6); PG8_BAR;
    }
    for (;;) {
        const bool has_next = S.next(ui + 1, nxt);
        const char* nA = has_next ? (const char*)g.A + (size_t)arow(nxt.pm) * (size_t)K * 2 : cA; const char* nB = has_next ? (const char*)g.Bt + (size_t)nxt.pn * tstep : cB;
        for (int t = 0; t < nt; t += 2) {
            const bool last = (t == nt - 2);
            long adjA1 = 0, adjA2 = 0, adjB2 = 0;
            if constexpr (Epi::HAS_MID) { adjA1 = (t >= nt1) ? g.dA - (long)nt1 * (long)kstep : 0; adjA2 = (t + 2 >= nt1) ? g.dA - (long)nt1 * (long)kstep : 0; adjB2 = (t + 2 >= nt1) ? g.dB - (long)nt1 * (long)kstep : 0; }
            if constexpr (Epi::HAS_MID) { if (t == nt1) E.mid(acc, cur, wr, wc, fr, fq); }
            const char* a1 = cA + (size_t)(t + 1) * kstep + adjA1;
            const char* a2 = last ? nA : cA + (size_t)(t + 2) * kstep + adjA2; const char* b2 = last ? nB : cB + (size_t)(t + 2) * kstep + adjB2;
            const char* a3 = a2 + kstep; const char* b3 = b2 + kstep;
            if (last && has_next) S.a_ready(nxt);
            if constexpr (SP2) {
            PG8_LDB(B0, 0, 0); PG8_LDB(B1, 0, 1); PG8_SCHED; PG8_LDA(At, 0, 0); PG8_STAGE(PG8_SA(1, 1), a1 + hstep, voffA);
            PG8_WAIT_V(8); PG8_WAIT_L(0); PG8_BAR; PG8_MMA(0, 0, At, B0); PG8_MMA(0, 1, At, B1); PG8_BAR; PG8_SCHED;
            PG8_LDA(At, 0, 1); PG8_STAGE(PG8_SB(0, 0), b2, voffB); PG8_STAGE(PG8_SB(0, 1), b2 + hstep, voffB); PG8_STAGE(PG8_SA(0, 0), a2, voffA);
            PG8_WAIT_V(8); PG8_WAIT_L(0); PG8_BAR; PG8_MMA(1, 0, At, B0); PG8_MMA(1, 1, At, B1); PG8_BAR; PG8_SCHED;
            PG8_LDB(B0, 1, 0); PG8_LDB(B1, 1, 1); PG8_SCHED; PG8_LDA(At, 1, 0); PG8_STAGE(PG8_SA(0, 1), a2 + hstep, voffA);
            PG8_WAIT_V(8); PG8_WAIT_L(0); PG8_BAR; PG8_MMA(0, 0, At, B0); PG8_MMA(0, 1, At, B1); PG8_BAR; PG8_SCHED;
            PG8_LDA(At, 1, 1); PG8_STAGE(PG8_SB(1, 0), b3, voffB); PG8_STAGE(PG8_SB(1, 1), b3 + hstep, voffB); PG8_STAGE(PG8_SA(1, 0), a3, voffA);
            PG8_WAIT_V(8); PG8_WAIT_L(0); PG8_BAR; PG8_MMA(1, 0, At, B0); PG8_MMA(1, 1, At, B1); PG8_BAR; PG8_SCHED;
            } else {
            PG8_LDB(B0, 0, 0); PG8_SCHED; PG8_LDA(At, 0, 0); PG8_STAGE(PG8_SA(1, 1), a1 + hstep, voffA);
            PG8_WAIT_L(8); PG8_BAR; PG8_WAIT_L(0); PG8_MMA(0, 0, At, B0); PG8_BAR; PG8_SCHED;
            PG8_LDB(B1, 0, 1); PG8_STAGE(PG8_SB(0, 0), b2, voffB);
            PG8_BAR; PG8_WAIT_L(0); PG8_MMA(0, 1, At, B1); PG8_BAR;
            PG8_LDA(At, 0, 1); PG8_STAGE(PG8_SA(0, 0), a2, voffA);
            PG8_BAR; PG8_WAIT_L(0); PG8_MMA(1, 0, At, B0); PG8_BAR; PG8_SCHED;
            PG8_STAGE(PG8_SB(0, 1), b2 + hstep, voffB);
            PG8_WAIT_V(6); PG8_BAR; PG8_MMA(1, 1, At, B1); PG8_BAR;
            PG8_LDB(B0, 1, 0); PG8_SCHED; PG8_LDA(At, 1, 0); PG8_STAGE(PG8_SA(0, 1), a2 + hstep, voffA);
            PG8_WAIT_L(8); PG8_BAR; PG8_WAIT_L(0); PG8_MMA(0, 0, At, B0); PG8_BAR; PG8_SCHED;
            PG8_LDB(B1, 1, 1); PG8_STAGE(PG8_SB(1, 0), b3, voffB);
            PG8_BAR; PG8_WAIT_L(0); PG8_MMA(0, 1, At, B1); PG8_BAR;
            PG8_LDA(At, 1, 1); PG8_STAGE(PG8_SA(1, 0), a3, voffA);
            PG8_BAR; PG8_WAIT_L(0); PG8_MMA(1, 0, At, B0); PG8_BAR; PG8_SCHED;
            PG8_STAGE(PG8_SB(1, 1), b3 + hstep, voffB);
            PG8_WAIT_V(6); PG8_BAR; PG8_MMA(1, 1, At, B1); PG8_BAR;
            }
        }
        if constexpr (ALIGN_EPI) { if (wr == 0) PG8_BAR; }
        if constexpr (!Epi::AFTER_DRAIN) { E(acc, cur, wr, wc, fr, fq); S.done(cur); }
        if (!has_next) break;
#pragma unroll
        for (int a = 0; a < 2; ++a)
#pragma unroll
            for (int b = 0; b < 2; ++b)
#pragma unroll
                for (int m = 0; m < 4; ++m)
#pragma unroll
                    for (int n = 0; n < 2; ++n) acc[a][b][m][n] = (f32x4){0.f, 0.f, 0.f, 0.f};
        cur = nxt; cA = nA; cB = nB; ++ui;
        if constexpr (ALIGN_EPI) { if (wr == 1) PG8_BAR; }
    }
    PG8_WAIT_V(0);
    if constexpr (!ALIGN_EPI) { if (wr == 0) PG8_BAR; }
    PG8_BAR;
    if constexpr (Epi::AFTER_DRAIN) { E.fused(acc, cur, wr, wc, fr, fq, lds, wid, lane); S.done(cur); }
#undef PG8_SA
#undef PG8_SB
#undef PG8_STAGE
#undef PG8_LDA
#undef PG8_LDB
#undef PG8_MMA
#undef PG8_WAIT_V
#undef PG8_WAIT_L
#undef PG8_BAR
#undef PG8_SCHED
}
}

namespace pg8 {
typedef unsigned u32x2 __attribute__((ext_vector_type(2)));
__device__ __forceinline__ float sigm(float x) { return __builtin_amdgcn_rcpf(1.0f + __expf(-x)); }
__device__ __forceinline__ void unpack8(const u32x4 w, float (&f)[8]) {
#pragma unroll
    for (int i = 0; i < 4; ++i) { f[2 * i] = __uint_as_float(w[i] << 16); f[2 * i + 1] = __uint_as_float(w[i] & 0xffff0000u); }
}
__device__ __forceinline__ u32x4 pack8f(const f32x4 a, const f32x4 b) { u32x4 w; w.x = cvt_pk_bf16(a[0], a[1]); w.y = cvt_pk_bf16(a[2], a[3]); w.z = cvt_pk_bf16(b[0], b[1]); w.w = cvt_pk_bf16(b[2], b[3]); return w; }
#define EPI_LOOP_AM _Pragma("unroll") for (int ai = 0; ai < 2; ++ai) _Pragma("unroll") for (int m = 0; m < 4; ++m)

__device__ __forceinline__ float dpp_shr1(float old, float x) { return __builtin_bit_cast(float, __builtin_amdgcn_update_dpp(__builtin_bit_cast(int, old), __builtin_bit_cast(int, x), 0x111, 0xf, 0xf, false)); }
__device__ __forceinline__ float dpp_shr2(float old, float x) { return __builtin_bit_cast(float, __builtin_amdgcn_update_dpp(__builtin_bit_cast(int, old), __builtin_bit_cast(int, x), 0x112, 0xf, 0xf, false)); }
__device__ __forceinline__ float dpp_ror1(float x) { return __builtin_bit_cast(float, __builtin_amdgcn_update_dpp(0, __builtin_bit_cast(int, x), 0x121, 0xf, 0xf, false)); }
__device__ __forceinline__ float dpp_ror2(float x) { return __builtin_bit_cast(float, __builtin_amdgcn_update_dpp(0, __builtin_bit_cast(int, x), 0x122, 0xf, 0xf, false)); }
struct EpiProj {
    static constexpr bool PERM = true, AFTER_DRAIN = false, HAS_MID = false;
    bf16_t *Q; size_t qkv_stride; bf16_t *YC, *GA, *GC; const float* cw;     float *CUHEAD, *GBHEAD, *CUTAIL; PG8_LAS float* halo;
    __device__ __forceinline__ void operator()(const f32x4 (&acc)[2][2][4][2], const Unit& u, int wr, int wc, int fr, int fq) const {
        const int row0 = arow(u.pm) + wr * 64 + fr; const int pn = u.pn;
        if (pn < 12) {
            bf16_t* base = Q + (size_t)(pn >> 2) * qkv_stride; const int col0 = (pn & 3) * 256 + wc * 32 + 8 * fq;
            EPI_LOOP_AM { bf16_t* rowp = base + (size_t)(row0 + ai * HALF + m * 16) * 1024 + col0;
#pragma unroll
                for (int bj = 0; bj < 2; ++bj) *(u32x4*)(rowp + bj * HALF) = pack8f(acc[ai][bj][m][0], acc[ai][bj][m][1]); }
        } else if (pn < 28) {
            const int lch = 16 * wc + 4 * fq, ch0 = 64 * (pn - 12) + lch;
            f32x4 cu[2][4];
            EPI_LOOP_AM cu[ai][m] = acc[ai][0][m][1] * acc[ai][1][m][0];
            if (fr >= 14) {
#pragma unroll
                for (int ai = 0; ai < 2; ++ai) *(PG8_LAS f32x4*)(halo + ((2 * ai + wr) * 2 + (fr - 14)) * 64 + lch) = cu[ai][3];
                if (wr == 1) *(f32x4*)(CUTAIL + ((size_t)u.pm * 2 + (fr - 14)) * 1024 + ch0) = cu[1][3];
            }
            if (fr < 2 && wr == 0) { *(f32x4*)(CUHEAD + ((size_t)u.pm * 2 + fr) * 1024 + ch0) = cu[0][0]; *(f32x4*)(GBHEAD + ((size_t)u.pm * 2 + fr) * 1024 + ch0) = acc[0][0][0][0]; }
            const f32x4 w0 = *(const f32x4*)(cw + ch0), w1 = *(const f32x4*)(cw + 1024 + ch0), w2 = *(const f32x4*)(cw + 2048 + ch0);
            asm volatile("s_waitcnt lgkmcnt(0)" ::: "memory"); __builtin_amdgcn_s_barrier(); asm volatile("" ::: "memory");
#pragma unroll
            for (int ai = 0; ai < 2; ++ai) { const int sl = 2 * ai + wr;
#pragma unroll
                for (int m = 0; m < 4; ++m) { f32x4 h1 = {0.f, 0.f, 0.f, 0.f}, h2 = h1, yc, gg;
                    if (m == 0 && sl > 0) { h2 = *(const PG8_LAS f32x4*)(halo + ((sl - 1) * 2 + 0) * 64 + lch); h1 = *(const PG8_LAS f32x4*)(halo + ((sl - 1) * 2 + 1) * 64 + lch); }
#pragma unroll
                    for (int e = 0; e < 4; ++e) { const float x = cu[ai][m][e]; float o1, o2;
                        if (m == 0) { o1 = h1[e]; o2 = (fr == 0) ? h2[e] : h1[e]; } else { const float g = cu[ai][m - 1][e]; o1 = dpp_ror1(g); o2 = dpp_ror2(g); }
                        const float p1 = dpp_shr1(o1, x), p2 = dpp_shr2(o2, x);
                        yc[e] = acc[ai][0][m][0][e] * (w0[e] * p2 + w1[e] * p1 + w2[e] * x); gg[e] = sigm(acc[ai][1][m][1][e]); }
                    const size_t off = (size_t)(row0 + ai * HALF + m * 16) * 1024 + ch0;
                    u32x2 oy, og; oy.x = cvt_pk_bf16(yc[0], yc[1]); oy.y = cvt_pk_bf16(yc[2], yc[3]); og.x = cvt_pk_bf16(gg[0], gg[1]); og.y = cvt_pk_bf16(gg[2], gg[3]);
                    *(u32x2*)(YC + off) = oy; *(u32x2*)(GC + off) = og; } }
        } else {
            const int col0 = (pn - 28) * 256 + wc * 32 + 8 * fq;
            EPI_LOOP_AM { bf16_t* rowp = GA + (size_t)(row0 + ai * HALF + m * 16) * 1024 + col0;
#pragma unroll
                for (int bj = 0; bj < 2; ++bj) { f32x4 a = acc[ai][bj][m][0], bb = acc[ai][bj][m][1];
#pragma unroll
                    for (int e = 0; e < 4; ++e) { a[e] = sigm(a[e]); bb[e] = sigm(bb[e]); }
                    *(u32x4*)(rowp + bj * HALF) = pack8f(a, bb); } }
        }
    }
};
template <bool ADD> struct EpiGate {
    static constexpr bool PERM = true, AFTER_DRAIN = false, HAS_MID = false;
    const bf16_t* G; const bf16_t* Tin; bf16_t* O;
    __device__ __forceinline__ void operator()(const f32x4 (&acc)[2][2][4][2], const Unit& u, int wr, int wc, int fr, int fq) const {
        const int row0 = arow(u.pm) + wr * 64 + fr; const int col0 = u.pn * 256 + wc * 32 + 8 * fq;
        EPI_LOOP_AM { const size_t off = (size_t)(row0 + ai * HALF + m * 16) * 1024 + col0;
#pragma unroll
            for (int bj = 0; bj < 2; ++bj) { float g[8]; unpack8(*(const u32x4*)(G + off + bj * HALF), g);
                f32x4 a = acc[ai][bj][m][0], b = acc[ai][bj][m][1];
#pragma unroll
                for (int e = 0; e < 4; ++e) { a[e] *= g[e]; b[e] *= g[4 + e]; }
                if (ADD) { float t[8]; unpack8(*(const u32x4*)(Tin + off + bj * HALF), t);
#pragma unroll
                    for (int e = 0; e < 4; ++e) { a[e] += t[e]; b[e] += t[4 + e]; } }
                *(u32x4*)(O + off + bj * HALF) = pack8f(a, b); } }
    }
};
struct EpiRes {
    static constexpr bool PERM = true, AFTER_DRAIN = false, HAS_MID = false;
    const float* base; float* out;
    __device__ __forceinline__ void operator()(const f32x4 (&acc)[2][2][4][2], const Unit& u, int wr, int wc, int fr, int fq) const {
        const int row0 = u.pm * 256 + wr * 64 + fr; const int col0 = u.pn * 256 + wc * 32 + 8 * fq;
        EPI_LOOP_AM { const size_t off = (size_t)(row0 + ai * HALF + m * 16) * 1024 + col0;
#pragma unroll
            for (int bj = 0; bj < 2; ++bj) { const f32x4 x0 = *(const f32x4*)(base + off + bj * HALF), x1 = *(const f32x4*)(base + off + bj * HALF + 4);
                *(f32x4*)(out + off + bj * HALF) = x0 + acc[ai][bj][m][0]; *(f32x4*)(out + off + bj * HALF + 4) = x1 + acc[ai][bj][m][1]; } }
    }
};
struct EpiResSS {
    static constexpr bool PERM = true, AFTER_DRAIN = false, HAS_MID = false;
    const float* base; float* out; bf16_t* Zb; float* SS;
    __device__ __forceinline__ void operator()(const f32x4 (&acc)[2][2][4][2], const Unit& u, int wr, int wc, int fr, int fq) const {
        const int row0 = u.pm * 256 + wr * 64 + fr; const int col0 = u.pn * 256 + wc * 32 + 8 * fq; const int brow0 = arow(u.pm) + wr * 64 + fr;
        EPI_LOOP_AM { const size_t off = (size_t)(row0 + ai * HALF + m * 16) * 1024 + col0; const size_t boff = (size_t)(brow0 + ai * HALF + m * 16) * 1024 + col0; float s = 0.f;
#pragma unroll
            for (int bj = 0; bj < 2; ++bj) { const f32x4 z0 = *(const f32x4*)(base + off + bj * HALF) + acc[ai][bj][m][0], z1 = *(const f32x4*)(base + off + bj * HALF + 4) + acc[ai][bj][m][1];
                *(u32x4*)(Zb + boff + bj * HALF) = pack8f(z0, z1);
                s += ((z0[0] * z0[0] + z0[1] * z0[1]) + (z0[2] * z0[2] + z0[3] * z0[3])) + ((z1[0] * z1[0] + z1[1] * z1[1]) + (z1[2] * z1[2] + z1[3] * z1[3])); }
            s += __shfl_xor(s, 16); s += __shfl_xor(s, 32);
            if (fq == 0) atomicAdd(SS + row0 + ai * HALF + m * 16, s); }
    }
};
struct EpiFfn {
    static constexpr bool PERM = true, AFTER_DRAIN = false, HAS_MID = false;
    bf16_t *Ab, *Vb; const float* SS;
    __device__ __forceinline__ void operator()(const f32x4 (&acc)[2][2][4][2], const Unit& u, int wr, int wc, int fr, int fq) const {
        const int row0 = arow(u.pm) + wr * 64 + fr; const int col0 = u.pn * 128 + wc * 32 + 8 * fq; const int srow0 = u.pm * 256 + wr * 64 + fr;
        EPI_LOOP_AM { const size_t off = (size_t)(row0 + ai * HALF + m * 16) * 2816 + col0; const float rs = 1.0f / sqrtf(SS[srow0 + ai * HALF + m * 16] * (1.0f / 1024.0f) + 1e-6f);
            *(u32x4*)(Ab + off) = pack8f(acc[ai][0][m][0] * rs, acc[ai][0][m][1] * rs); *(u32x4*)(Vb + off) = pack8f(acc[ai][1][m][0] * rs, acc[ai][1][m][1] * rs); }
    }
};
struct EpiFfnConv {
    static constexpr bool PERM = true, AFTER_DRAIN = false, HAS_MID = false;
    bf16_t* Sb; const float* SS; const float* cw; float *AHEAD, *VHEAD, *ATAIL; PG8_LAS float* halo;
    __device__ __forceinline__ void operator()(const f32x4 (&acc)[2][2][4][2], const Unit& u, int wr, int wc, int fr, int fq) const {
        const int row0 = arow(u.pm) + wr * 64 + fr, chan0 = u.pn * 128 + wc * 32 + 8 * fq, srow0 = u.pm * 256 + wr * 64 + fr, lcol = wc * 32 + 8 * fq;
        f32x4 av[2][4][2]; float rs[2][4];
        EPI_LOOP_AM { rs[ai][m] = 1.0f / sqrtf(SS[srow0 + ai * HALF + m * 16] * (1.0f / 1024.0f) + 1e-6f); av[ai][m][0] = acc[ai][0][m][0] * rs[ai][m]; av[ai][m][1] = acc[ai][0][m][1] * rs[ai][m]; }
        if (fr >= 14) {
#pragma unroll
            for (int ai = 0; ai < 2; ++ai)
#pragma unroll
                for (int n = 0; n < 2; ++n) *(PG8_LAS f32x4*)(halo + ((2 * ai + wr) * 2 + (fr - 14)) * 128 + lcol + 4 * n) = av[ai][3][n];
            if (wr == 1) {
#pragma unroll
                for (int n = 0; n < 2; ++n) *(f32x4*)(ATAIL + ((size_t)u.pm * 2 + (fr - 14)) * 2816 + chan0 + 4 * n) = av[1][3][n]; }
        }
        if (fr < 2 && wr == 0) {
#pragma unroll
            for (int n = 0; n < 2; ++n) { *(f32x4*)(AHEAD + ((size_t)u.pm * 2 + fr) * 2816 + chan0 + 4 * n) = av[0][0][n]; *(f32x4*)(VHEAD + ((size_t)u.pm * 2 + fr) * 2816 + chan0 + 4 * n) = acc[0][1][0][n] * rs[0][0]; } }
        f32x4 w0[2], w1[2], w2[2];
#pragma unroll
        for (int n = 0; n < 2; ++n) { w0[n] = *(const f32x4*)(cw + chan0 + 4 * n); w1[n] = *(const f32x4*)(cw + 2816 + chan0 + 4 * n); w2[n] = *(const f32x4*)(cw + 2 * 2816 + chan0 + 4 * n); }
        asm volatile("s_waitcnt lgkmcnt(0)" ::: "memory"); __builtin_amdgcn_s_barrier(); asm volatile("" ::: "memory");
#pragma unroll
        for (int ai = 0; ai < 2; ++ai) {
            const int sl = 2 * ai + wr;
#pragma unroll
            for (int m = 0; m < 4; ++m) { f32x4 sv[2];
#pragma unroll
                for (int n = 0; n < 2; ++n) { f32x4 h1, h2;
                    if (m == 0) { if (sl > 0) { h2 = *(const PG8_LAS f32x4*)(halo + ((sl - 1) * 2 + 0) * 128 + lcol + 4 * n); h1 = *(const PG8_LAS f32x4*)(halo + ((sl - 1) * 2 + 1) * 128 + lcol + 4 * n); } else { h1 = (f32x4){0.f, 0.f, 0.f, 0.f}; h2 = h1; } }
#pragma unroll
                    for (int e = 0; e < 4; ++e) { const float x = av[ai][m][n][e]; float o1, o2;
                        if (m == 0) { o1 = h1[e]; o2 = (fr == 0) ? h2[e] : h1[e]; } else { const float g = av[ai][m - 1][n][e]; o1 = dpp_ror1(g); o2 = dpp_ror2(g); }
                        const float p1 = dpp_shr1(o1, x), p2 = dpp_shr2(o2, x);
                        const float cv = w0[n][e] * p2 + w1[n][e] * p1 + w2[n][e] * x;
                        sv[n][e] = cv * sigm(cv) * (acc[ai][1][m][n][e] * rs[ai][m]); } }
                *(u32x4*)(Sb + (size_t)(row0 + ai * HALF + m * 16) * 2816 + chan0) = pack8f(sv[0], sv[1]); } }
    }
};
struct EpiResNorm {
    static constexpr bool PERM = true, AFTER_DRAIN = false, HAS_MID = false;
    const bf16_t* base; float* out; const float* g; float* xb; unsigned* cnt; PG8_LAS float* P; PG8_LAS float* Srow;
    __device__ __forceinline__ void operator()(f32x4 (&acc)[2][2][4][2], const Unit& u, int wr, int wc, int fr, int fq) const {
        const int row0 = u.pm * 256 + wr * 64 + fr; const int col0 = u.pn * 256 + wc * 32 + 8 * fq; const int tid = threadIdx.x, wid = tid >> 6, lane = tid & 63; const int brow0 = arow(u.pm) + wr * 64 + fr;
        EPI_LOOP_AM { const size_t boff = (size_t)(brow0 + ai * HALF + m * 16) * 1024 + col0; float s = 0.f;
#pragma unroll
            for (int bj = 0; bj < 2; ++bj) { float zb[8]; unpack8(*(const u32x4*)(base + boff + bj * HALF), zb);
                acc[ai][bj][m][0] += (f32x4){zb[0], zb[1], zb[2], zb[3]}; acc[ai][bj][m][1] += (f32x4){zb[4], zb[5], zb[6], zb[7]};
                const f32x4 z0 = acc[ai][bj][m][0], z1 = acc[ai][bj][m][1];
                s += ((z0[0] * z0[0] + z0[1] * z0[1]) + (z0[2] * z0[2] + z0[3] * z0[3])) + ((z1[0] * z1[0] + z1[1] * z1[1]) + (z1[2] * z1[2] + z1[3] * z1[3])); }
            s += __shfl_xor(s, 16); s += __shfl_xor(s, 32);
            if (fq == 0) P[(ai * HALF + wr * 64 + m * 16 + fr) * 4 + wc] = s; }
        asm volatile("s_waitcnt lgkmcnt(0)" ::: "memory"); __builtin_amdgcn_s_barrier(); asm volatile("" ::: "memory");
        if (tid < 256) { const f32x4 p = *(const PG8_LAS f32x4*)(P + tid * 4);
            __hip_atomic_store(xb + ((size_t)u.pm * 256 + tid) * 4 + u.pn, (p[0] + p[1]) + (p[2] + p[3]), __ATOMIC_RELAXED, __HIP_MEMORY_SCOPE_AGENT);
            asm volatile("s_waitcnt vmcnt(0)" ::: "memory");
            if (lane == 0) __hip_atomic_fetch_add(cnt + 64 * u.pm, 1u, __ATOMIC_RELAXED, __HIP_MEMORY_SCOPE_AGENT); }
        if (wid == 0) { unsigned sp = 0;
            while ((unsigned)__builtin_amdgcn_readfirstlane(__hip_atomic_load(cnt + 64 * u.pm, __ATOMIC_RELAXED, __HIP_MEMORY_SCOPE_AGENT)) < 16u) { __builtin_amdgcn_s_sleep(2); if (++sp > (1u << 22)) break; }
            __builtin_amdgcn_fence(__ATOMIC_ACQUIRE, "agent"); }
        asm volatile("s_waitcnt vmcnt(0) lgkmcnt(0)" ::: "memory"); __builtin_amdgcn_s_barrier(); asm volatile("" ::: "memory");
        if (tid < 256) { const float* sl = xb + ((size_t)u.pm * 256 + tid) * 4; float t = 0.f;
#pragma unroll
            for (int k = 0; k < 4; ++k) t += __hip_atomic_load(sl + k, __ATOMIC_RELAXED, __HIP_MEMORY_SCOPE_AGENT);
            Srow[tid] = 1.0f / sqrtf(t * (1.0f / 1024.0f) + 1e-6f); }
        asm volatile("s_waitcnt lgkmcnt(0)" ::: "memory"); __builtin_amdgcn_s_barrier(); asm volatile("" ::: "memory");
        f32x4 gv[2][2];
#pragma unroll
        for (int bj = 0; bj < 2; ++bj) { gv[bj][0] = *(const f32x4*)(g + col0 + bj * HALF); gv[bj][1] = *(const f32x4*)(g + col0 + bj * HALF + 4); }
        EPI_LOOP_AM { const int r = ai * HALF + wr * 64 + m * 16 + fr; const float rs = Srow[r]; const size_t off = (size_t)(row0 + ai * HALF + m * 16) * 1024 + col0;
#pragma unroll
            for (int bj = 0; bj < 2; ++bj) { *(f32x4*)(out + off + bj * HALF) = (acc[ai][bj][m][0] * rs) * gv[bj][0]; *(f32x4*)(out + off + bj * HALF + 4) = (acc[ai][bj][m][1] * rs) * gv[bj][1]; } }
    }
};
struct EpiGate2 {
    static constexpr bool PERM = true, AFTER_DRAIN = false, HAS_MID = true;
    const bf16_t* GA; const bf16_t* GC; bf16_t* O;
    __device__ __forceinline__ void mid(f32x4 (&acc)[2][2][4][2], const Unit& u, int wr, int wc, int fr, int fq) const {
        int frE = fr, fqE = fq; asm volatile("" : "+v"(frE), "+v"(fqE));
        const int row0 = arow(u.pm) + wr * 64 + frE; const int col0 = u.pn * 256 + wc * 32 + 8 * fqE;
        EPI_LOOP_AM { const size_t off = (size_t)(row0 + ai * HALF + m * 16) * 1024 + col0;
#pragma unroll
            for (int bj = 0; bj < 2; ++bj) { float ga[8], gc[8]; unpack8(*(const u32x4*)(GA + off + bj * HALF), ga); unpack8(*(const u32x4*)(GC + off + bj * HALF), gc);
#pragma unroll
                for (int e = 0; e < 4; ++e) { acc[ai][bj][m][0][e] *= ga[e] * __builtin_amdgcn_rcpf(gc[e]); acc[ai][bj][m][1][e] *= ga[4 + e] * __builtin_amdgcn_rcpf(gc[4 + e]); } }
            asm volatile("" ::: "memory"); }
    }
    __device__ __forceinline__ void operator()(const f32x4 (&acc)[2][2][4][2], const Unit& u, int wr, int wc, int fr, int fq) const {
        int frE = fr, fqE = fq; asm volatile("" : "+v"(frE), "+v"(fqE));
        const int row0 = arow(u.pm) + wr * 64 + frE; const int col0 = u.pn * 256 + wc * 32 + 8 * fqE;
        EPI_LOOP_AM { const size_t off = (size_t)(row0 + ai * HALF + m * 16) * 1024 + col0;
#pragma unroll
            for (int bj = 0; bj < 2; ++bj) { float gc[8]; unpack8(*(const u32x4*)(GC + off + bj * HALF), gc);
                f32x4 a = acc[ai][bj][m][0], bb = acc[ai][bj][m][1];
#pragma unroll
                for (int e = 0; e < 4; ++e) { a[e] *= gc[e]; bb[e] *= gc[4 + e]; }
                *(u32x4*)(O + off + bj * HALF) = pack8f(a, bb); } }
    }
};
}

namespace att {
constexpr int D = 128, RS = 1024;
constexpr float THR = 8.f;
constexpr bool WSKIP = false;
constexpr float SCALE = 0.08838834764831845f, INV_SCALE = 11.313708498984761f;
constexpr int NW = 8, QBLK = 32, KVBLK = 64, QB = NW * QBLK;
constexpr int SHM_V = KVBLK * D * 2, SHM_K = KVBLK * D * 2;
constexpr int BIAS_OFF = 2 * SHM_K + NW * 64 * 4;
constexpr int LDS_BYTES = 2 * SHM_V + 2 * SHM_K + NW * 64 * 4 + 2 * 64 * 4;
using bf16 = __hip_bfloat16;
typedef short bf16x8 __attribute__((ext_vector_type(8)));
typedef short s16x4 __attribute__((ext_vector_type(4)));
typedef float f32x16 __attribute__((ext_vector_type(16)));
typedef float f32x4 __attribute__((ext_vector_type(4)));
typedef unsigned u32x4 __attribute__((ext_vector_type(4)));
template <class A, class Bt> struct same_t { static constexpr bool v = false; };
template <class A> struct same_t<A, A> { static constexpr bool v = true; };
#define KSWZ(row, colB) ((row) * 256 + ((colB) ^ (((row) & 7) << 4)))
#define SBAR() __builtin_amdgcn_sched_barrier(0)
__device__ __forceinline__ int v_st(int k, int c) { const int kk = (k & ~0xC) | ((k & 4) << 1) | ((k & 8) >> 1); return ((kk >> 3) * 4 + (c >> 5)) * 512 + ((kk & 7) * 32 + (c & 31)) * 2; }
__device__ __forceinline__ int v_rd_base(int lane) { return ((lane & 3) << 3) | (((lane >> 2) & 3) << 6) | (((lane >> 4) & 1) << 5) | (((lane >> 5) & 1) << 8); }
constexpr int v_rd_off(int d0, int ks, int half) { return d0 * 512 + ks * 4096 + half * 2048; }
__device__ __forceinline__ int crow(int r, int hi) { return (r & 3) + 8 * (r >> 2) + 4 * hi; }
__device__ __forceinline__ unsigned cvtpk(float lo, float hi) {
    unsigned r; asm volatile("v_cvt_pk_bf16_f32 %0, %1, %2" : "=v"(r) : "v"(lo), "v"(hi)); return r;
}
__device__ __forceinline__ bf16x8 pack8(f32x4 a, f32x4 b) {
    u32x4 w = {cvtpk(a[0], a[1]), cvtpk(a[2], a[3]), cvtpk(b[0], b[1]), cvtpk(b[2], b[3])};
    return *reinterpret_cast<bf16x8*>(&w);
}
template <class T> __device__ __forceinline__ bf16x8 load8(const T* p) {
    if constexpr (same_t<T, float>::v) { return pack8(*(const f32x4*)p, *(const f32x4*)(p + 4)); }
    else { return *reinterpret_cast<const bf16x8*>(p); }
}
__device__ __forceinline__ void mask_tile(f32x16& p0, f32x16& p1, int dq, unsigned W) {
    const float NEG = -__builtin_inff();
#pragma unroll
    for (int r = 0; r < 16; ++r) {
        const int c = (r & 3) + 8 * (r >> 2);
        if ((unsigned)(dq - c) >= W) p0[r] = NEG;
        if ((unsigned)(dq - c - 32) >= W) p1[r] = NEG;
    }
}
__device__ __forceinline__ void partialSM(f32x16& p0, f32x16& p1, float& m_reg, float& mn, float& alpha) {
    float pmax = p0[0]; for (int r = 1; r < 16; ++r) pmax = fmaxf(pmax, p0[r]); for (int r = 0; r < 16; ++r) pmax = fmaxf(pmax, p1[r]);
    { auto rr = __builtin_amdgcn_permlane32_swap(__float_as_uint(pmax), __float_as_uint(pmax), false, false);
      pmax = fmaxf(__uint_as_float(rr[0]), __uint_as_float(rr[1])); }
    constexpr float C2 = 1.4426950408889634f * SCALE;
    if (__builtin_expect(__all((pmax - m_reg) * SCALE <= THR), 1)) { mn = m_reg; alpha = 1.f; }
    else { mn = fmaxf(m_reg, pmax); alpha = __builtin_amdgcn_exp2f((m_reg - mn) * C2); m_reg = mn; }
    const float mnL = -mn * C2;
    for (int r = 0; r < 16; ++r) p0[r] = fmaf(p0[r], C2, mnL); for (int r = 0; r < 16; ++r) p1[r] = fmaf(p1[r], C2, mnL);
    for (int r = 0; r < 16; ++r) p0[r] = __builtin_amdgcn_exp2f(p0[r]);
}
__device__ __forceinline__ void finishSM(f32x16& p0, f32x16& p1, float alpha, float& l_reg, bf16x8& pa0, bf16x8& pa1, bf16x8& pa2, bf16x8& pa3) {
    for (int r = 0; r < 16; ++r) p1[r] = __builtin_amdgcn_exp2f(p1[r]);
    float ps = 0; for (int r = 0; r < 16; ++r) ps += p0[r]; for (int r = 0; r < 16; ++r) ps += p1[r];
    { auto rr = __builtin_amdgcn_permlane32_swap(__float_as_uint(ps), __float_as_uint(ps), false, false);
      ps = __uint_as_float(rr[0]) + __uint_as_float(rr[1]); }
    l_reg = l_reg * alpha + ps;
#define PK4(P, B_, OUT) do { unsigned a0 = cvtpk(P[B_+0], P[B_+1]), a1 = cvtpk(P[B_+2], P[B_+3]);                          \
        unsigned b0 = cvtpk(P[B_+4], P[B_+5]), b1 = cvtpk(P[B_+6], P[B_+7]);                                             \
        auto r0 = __builtin_amdgcn_permlane32_swap(a0, b0, false, false); auto r1 = __builtin_amdgcn_permlane32_swap(a1, b1, false, false); \
        u32x4 w = {r0[0], r1[0], r0[1], r1[1]}; OUT = *reinterpret_cast<bf16x8*>(&w); } while (0)
    PK4(p0, 0, pa0); PK4(p0, 8, pa1); PK4(p1, 0, pa2); PK4(p1, 8, pa3);
#undef PK4
}
template <int KB, bool SK>
__device__ __forceinline__ void qkt(f32x16& p0, f32x16& p1, const char* K_lds, int r32, int hi, const bf16x8* qr, bool act) {
    if (SK && !act) { const float NEG = -__builtin_inff();
#pragma unroll
        for (int r = 0; r < 16; ++r) { p0[r] = NEG; p1[r] = NEG; } return; }
    { unsigned ba_; asm volatile("v_lshl_add_u32 %0, %1, 4, %2" : "=v"(ba_) : "v"(hi), "s"((unsigned)(uintptr_t)(K_lds + BIAS_OFF + KB * 256)));
      const __attribute__((address_space(3))) float* bl = (const __attribute__((address_space(3))) float*)(uintptr_t)ba_;
#pragma unroll
      for (int g_ = 0; g_ < 4; ++g_) { const f32x4 a_ = *(const __attribute__((address_space(3))) f32x4*)(bl + 8 * g_), b_ = *(const __attribute__((address_space(3))) f32x4*)(bl + 32 + 8 * g_);
        p0[4 * g_] = a_[0]; p0[4 * g_ + 1] = a_[1]; p0[4 * g_ + 2] = a_[2]; p0[4 * g_ + 3] = a_[3]; p1[4 * g_] = b_[0]; p1[4 * g_ + 1] = b_[1]; p1[4 * g_ + 2] = b_[2]; p1[4 * g_ + 3] = b_[3]; } }
    const unsigned kb0 = (unsigned)(uintptr_t)(K_lds + KSWZ(r32, (hi * 8) * 2));
#pragma unroll
    for (int d0 = 0; d0 < 8; ++d0) { unsigned ax = kb0; if (d0 & 3) asm volatile("v_xor_b32_e32 %0, %2, %1" : "=v"(ax) : "v"(kb0), "n"((d0 & 3) << 5));
        const __attribute__((address_space(3))) char* a = (const __attribute__((address_space(3))) char*)(uintptr_t)ax + KB * SHM_K + (d0 >> 2) * 128;
        bf16x8 b0 = *(const __attribute__((address_space(3))) bf16x8*)(a);
        bf16x8 b1 = *(const __attribute__((address_space(3))) bf16x8*)(a + 32 * 256);
        p0 = __builtin_amdgcn_mfma_f32_32x32x16_bf16(b0, qr[d0], p0, 0, 0, 0);
        p1 = __builtin_amdgcn_mfma_f32_32x32x16_bf16(b1, qr[d0], p1, 0, 0, 0); }
}
template <int VB, bool SK>
__device__ __forceinline__ void pv_tile(f32x16* o, int vb0, bf16x8 pa0, bf16x8 pa1, bf16x8 pa2, bf16x8 pa3, bool act) {
    if (SK && !act) return;
#define TRRD(dst, off) asm volatile("ds_read_b64_tr_b16 %0, %1 offset:%2" : "=&v"(dst) : "v"(vb0), "i"(off) : "memory")
#define PV_D0(d0) do { s16x4 l0, l1, l2, l3, h0, h1, h2, h3; constexpr int b_ = VB * SHM_V + v_rd_off(d0, 0, 0);     \
        TRRD(l0, b_); TRRD(h0, b_ + 2048); TRRD(l1, b_ + 4096); TRRD(h1, b_ + 6144); TRRD(l2, b_ + 8192); TRRD(h2, b_ + 10240); TRRD(l3, b_ + 12288); TRRD(h3, b_ + 14336); \
        asm volatile("s_waitcnt lgkmcnt(0)" ::: "memory"); SBAR();                 \
        o[d0] = __builtin_amdgcn_mfma_f32_32x32x16_bf16(pa0, (bf16x8){l0[0], l0[1], l0[2], l0[3], h0[0], h0[1], h0[2], h0[3]}, o[d0], 0, 0, 0);   \
        o[d0] = __builtin_amdgcn_mfma_f32_32x32x16_bf16(pa1, (bf16x8){l1[0], l1[1], l1[2], l1[3], h1[0], h1[1], h1[2], h1[3]}, o[d0], 0, 0, 0);   \
        o[d0] = __builtin_amdgcn_mfma_f32_32x32x16_bf16(pa2, (bf16x8){l2[0], l2[1], l2[2], l2[3], h2[0], h2[1], h2[2], h2[3]}, o[d0], 0, 0, 0);   \
        o[d0] = __builtin_amdgcn_mfma_f32_32x32x16_bf16(pa3, (bf16x8){l3[0], l3[1], l3[2], l3[3], h3[0], h3[1], h3[2], h3[3]}, o[d0], 0, 0, 0); } while (0)
    PV_D0(0); PV_D0(1); PV_D0(2); PV_D0(3);
#undef PV_D0
#undef TRRD
}

template <class TIn, class TOut> struct BlockRef { const TIn* Q; const TIn* K; const TIn* V; TOut* O; const float* C; int P0; };
template <class TIn> struct Seam {
    bf16x8 qr[8];
    bf16x8 st_v0, st_v1, st_k0, st_k1; f32x4 sf0, sf1, sf2, sf3; float st_b;
    f32x4 tq[16];
};
__device__ __forceinline__ int swa_jlo(int P0, int W) { const int lowk = P0 - W + 1; return lowk > 0 ? lowk / KVBLK : 0; }
#define ROW(p, k0, rr) ((p) + (size_t)((k0) + (rr)) * RS + sc)
#define VMW() asm volatile("s_waitcnt vmcnt(0)" ::: "memory")
#define VMWN(n) asm volatile("s_waitcnt vmcnt(%0)" :: "i"(n) : "memory")
#define SLOAD_H(Kp, Vp, k0) do { S.st_v0 = load8<TIn>(ROW(Vp, k0, sr)); S.st_v1 = load8<TIn>(ROW(Vp, k0, 32 + sr));              \
                         S.st_k0 = load8<TIn>(ROW(Kp, k0, sr)); S.st_k1 = load8<TIn>(ROW(Kp, k0, 32 + sr)); } while (0)
#define SLOAD_B(Cp, cref, k0) do { S.st_b = (Cp)[(k0) + lane]; } while (0)
#define SWRITE_B(bf) do { unsigned wa_; asm volatile("v_lshl_add_u32 %0, %1, 2, %2" : "=v"(wa_) : "v"(lane), "s"((unsigned)(uintptr_t)(K_lds + BIAS_OFF))); ((__attribute__((address_space(3))) float*)(uintptr_t)wa_)[(bf) * 64] = S.st_b; } while (0)
#define SWRITE_HK(bf) do { *(bf16x8*)(K_lds + (bf) * SHM_K + kws) = S.st_k0; *(bf16x8*)(K_lds + (bf) * SHM_K + kws + 32 * 256) = S.st_k1; SWRITE_B(bf); } while (0)
#define SWRITE_HV(bf) do { *(bf16x8*)(V_lds + (bf) * SHM_V + vst0) = S.st_v0; *(bf16x8*)(V_lds + (bf) * SHM_V + vst0 + vst1_d) = S.st_v1; } while (0)
#define SWRITE_H(bf) do { SWRITE_HV(bf); SWRITE_HK(bf); } while (0)
#define SLOAD_F(p, k0) do { S.sf0 = *(const f32x4*)ROW(p, k0, sr); S.sf1 = *(const f32x4*)(ROW(p, k0, sr) + 4);                \
                            S.sf2 = *(const f32x4*)ROW(p, k0, 32 + sr); S.sf3 = *(const f32x4*)(ROW(p, k0, 32 + sr) + 4); } while (0)
#define SWRITE_KF(bf) do { *(bf16x8*)(K_lds + (bf) * SHM_K + kws) = pack8(S.sf0, S.sf1); *(bf16x8*)(K_lds + (bf) * SHM_K + kws + 32 * 256) = pack8(S.sf2, S.sf3); } while (0)
#define SWRITE_VF(bf) do { *(bf16x8*)(V_lds + (bf) * SHM_V + vst0) = pack8(S.sf0, S.sf1); *(bf16x8*)(V_lds + (bf) * SHM_V + vst0 + vst1_d) = pack8(S.sf2, S.sf3); } while (0)
template <class TIn, class TOut>
__device__ __forceinline__ void causal_swa_prime(const BlockRef<TIn, TOut>& cur, int W, char* lds, Seam<TIn>& S) {
    constexpr bool F32 = same_t<TIn, float>::v;
    const int tid = threadIdx.x, wid = __builtin_amdgcn_readfirstlane(tid >> 6), lane = tid & 63, r32 = lane & 31, hi = lane >> 5;
    const int sr = tid >> 4, sc = (tid & 15) * 8, kws = KSWZ(sr, sc * 2); char* K_lds = lds + 2 * SHM_V;
    const int kb0 = ((cur.P0 + QB - 1) / KVBLK) * KVBLK;
    for (int d0 = 0; d0 < 8; ++d0) S.qr[d0] = load8<TIn>(cur.Q + (size_t)(wid * QBLK + r32) * RS + d0 * 16 + hi * 8);
    if constexpr (F32) { SLOAD_F((const float*)cur.K, kb0); VMW(); SWRITE_KF(0); SBAR(); SLOAD_F((const float*)cur.V, kb0); }
    else { SLOAD_H(cur.K, cur.V, kb0); SLOAD_B(cur.C, 0, kb0); VMW(); SWRITE_HK(0); }
    __syncthreads();
}
template <class TIn, class TOut>
__device__ __forceinline__ void causal_swa_block(const BlockRef<TIn, TOut>& cur, const BlockRef<TIn, TOut>& nxt, int skv, int W, char* lds, Seam<TIn>& S) {
    constexpr bool F32 = same_t<TIn, float>::v;
    const int tid = threadIdx.x, wid = __builtin_amdgcn_readfirstlane(tid >> 6), lane = tid & 63, r32 = lane & 31, hi = lane >> 5;
    const int j_lo = swa_jlo(cur.P0, W);
    int j_hi = (cur.P0 + QB - 1) / KVBLK + 1; if (j_hi > skv / KVBLK) j_hi = skv / KVBLK;
    const int NT = j_hi - j_lo;
    const int kbn = ((nxt.P0 + QB - 1) / KVBLK) * KVBLK;
    const int qlo = cur.P0 + wid * QBLK, qm = qlo + r32 - 4 * hi;
    char* V_lds = lds; char* K_lds = lds + 2 * SHM_V;
    float* ws = (float*)(lds + 2 * SHM_V + 2 * SHM_K) + wid * 64; float* li_l = ws, * al_l = ws + 32;
    float m_reg = -1e30f, l_reg = 0; f32x16 o[4] = {};
    const int sr = tid >> 4, sc = (tid & 15) * 8, vst0 = v_st(sr, sc), kws = KSWZ(sr, sc * 2); constexpr int vst1_d = 4 * 4 * 512;
    const int vb0 = (int)(uintptr_t)V_lds + v_rd_base(lane);
    const TIn* Kh = cur.K; const TIn* Vh = cur.V;
#define RESC(a) do { if (__any((a) < 1.f)) { if (hi == 0) al_l[r32] = (a); asm volatile("s_waitcnt lgkmcnt(0)" ::: "memory");              \
                     for (int d_ = 0; d_ < 4; ++d_) for (int r = 0; r < 16; ++r) o[d_][r] *= al_l[crow(r, hi)]; } } while (0)
#define KBASE(t) ((j_hi - 1 - (t)) * KVBLK)
#define ACT(t) (KBASE(t) <= qlo + QBLK - 1 && KBASE(t) + KVBLK - 1 >= qlo - W + 1)
#define MASKT(P0_, P1_, t) do { const int kb_ = KBASE(t); if ((!SK || ACT(t)) && (kb_ + KVBLK - 1 > qlo || kb_ <= qlo + QBLK - 1 - W)) mask_tile(P0_, P1_, qm - kb_, (unsigned)W); } while (0)
    constexpr int NQL = F32 ? 16 : 8;
    constexpr bool SK = WSKIP && !F32;
#define SEAM_K0() do { VMWN(NQL); if constexpr (F32) { SWRITE_KF(0); SBAR(); SLOAD_F((const float*)nxt.V, kbn); } else { SWRITE_HK(0); } SBAR(); } while (0)
    f32x16 pA0, pA1, pB0, pB1; float mnA, mnB, alA, alB; bf16x8 pa0, pa1, pa2, pa3;
    if constexpr (F32) { VMW(); SWRITE_VF(0); SBAR(); } else { SWRITE_HV(0); SBAR(); }
    if (NT > 1) { if constexpr (F32) SLOAD_F((const float*)Kh, KBASE(1)); else { SLOAD_H(Kh, Vh, KBASE(1)); SLOAD_B(cur.C, 0, KBASE(1)); } }
    SBAR(); qkt<0, SK>(pA0, pA1, K_lds, r32, hi, S.qr, ACT(0));
    if constexpr (F32) { if (NT > 1) { VMW(); SWRITE_KF(1); SBAR(); SLOAD_F((const float*)Vh, KBASE(1)); } }
    MASKT(pA0, pA1, 0); partialSM(pA0, pA1, m_reg, mnA, alA);
    if (NT > 1) { VMW(); if constexpr (F32) { SWRITE_VF(1); SBAR(); if (NT > 2) SLOAD_F((const float*)Kh, KBASE(2)); } else SWRITE_H(1); }
    __syncthreads();
#define HALF_STEP(PX0, PX1, mnX, alX, PY0, PY1, alY, t, KB, VB, SB) do {                                                      \
        SBAR(); qkt<KB, SK>(PX0, PX1, K_lds, r32, hi, S.qr, ACT(t));                                             \
        finishSM(PY0, PY1, alY, l_reg, pa0, pa1, pa2, pa3); SBAR();                                                           \
        if ((t) + 1 < NT) { if constexpr (F32) { VMW(); SWRITE_KF(SB); SBAR(); SLOAD_F((const float*)Vh, KBASE((t) + 1)); }  \
                            else { SLOAD_H(Kh, Vh, KBASE((t) + 1)); SLOAD_B(cur.C, 0, KBASE((t) + 1)); } SBAR(); }                                               \
        pv_tile<VB, SK>(o, vb0, pa0, pa1, pa2, pa3, ACT((t) - 1)); MASKT(PX0, PX1, (t)); partialSM(PX0, PX1, m_reg, mnX, alX);                                        \
        __syncthreads();                                                                                                      \
        if ((t) + 1 < NT) { VMW(); if constexpr (F32) { SWRITE_VF(SB); SBAR(); if ((t) + 2 < NT) SLOAD_F((const float*)Kh, KBASE((t) + 2)); } \
                            else { SWRITE_H(SB); } }                                                                          \
        RESC(alX); __syncthreads(); } while (0)
    for (int t = 1; t + 1 < NT; t += 2) {
        HALF_STEP(pB0, pB1, mnB, alB, pA0, pA1, alA, t, 1, 0, 0);
        HALF_STEP(pA0, pA1, mnA, alA, pB0, pB1, alB, t + 1, 0, 1, 1);
    }
    const bool even = (NT & 1) == 0;
    if (even) { SBAR(); qkt<1, SK>(pB0, pB1, K_lds, r32, hi, S.qr, ACT(NT - 1)); SBAR(); }
#define QROW(e) (nxt.Q + (size_t)(wid * QBLK + r32) * RS + ((e) >> 1) * 16 + hi * 8 + ((e) & 1) * 4)
    if constexpr (F32) { SLOAD_F((const float*)nxt.K, kbn); SBAR();
#pragma unroll
        for (int e = 0; e < 8; ++e) S.tq[e] = *(const f32x4*)QROW(e); }
    else { SLOAD_H(nxt.K, nxt.V, kbn); SLOAD_B(nxt.C, 0, kbn); SBAR();
#pragma unroll
        for (int d0 = 0; d0 < 8; ++d0) S.qr[d0] = load8<TIn>(nxt.Q + (size_t)(wid * QBLK + r32) * RS + d0 * 16 + hi * 8); }
    SBAR();
    finishSM(pA0, pA1, alA, l_reg, pa0, pa1, pa2, pa3); SBAR();
    if constexpr (F32) {
#pragma unroll
        for (int e = 8; e < 16; ++e) S.tq[e] = *(const f32x4*)QROW(e); SBAR(); }
#undef QROW
    pv_tile<0, SK>(o, vb0, pa0, pa1, pa2, pa3, ACT(even ? NT - 2 : NT - 1));
    if (even) { MASKT(pB0, pB1, NT - 1); partialSM(pB0, pB1, m_reg, mnB, alB); __syncthreads(); RESC(alB);
        finishSM(pB0, pB1, alB, l_reg, pa0, pa1, pa2, pa3); SBAR(); pv_tile<1, SK>(o, vb0, pa0, pa1, pa2, pa3, ACT(NT - 1)); }
    SBAR(); SEAM_K0();
    if (hi == 0) li_l[r32] = l_reg; asm volatile("s_waitcnt lgkmcnt(0)" ::: "memory");
    float rli[16];
#pragma unroll
    for (int r = 0; r < 16; ++r) rli[r] = __builtin_amdgcn_rcpf(li_l[crow(r, hi)]);
    int lnE = (int)threadIdx.x; asm volatile("" : "+v"(lnE)); const int r32E = lnE & 31, hiE = (lnE >> 5) & 1;
    TOut* Ow = cur.O + (size_t)(wid * QBLK) * RS;
#pragma unroll
    for (int r = 0; r < 16; ++r) { const int orow = crow(r, hiE);
#pragma unroll
        for (int d0 = 0; d0 < 4; ++d0) { const float v = o[d0][r] * rli[r];
            if constexpr (same_t<TOut, float>::v) { Ow[(size_t)orow * RS + d0 * 32 + r32E] = v; }
            else { const float vn = __shfl_xor(v, 1);
                   if ((r32E & 1) == 0) *(unsigned*)(Ow + (size_t)orow * RS + d0 * 32 + r32E) = cvtpk(v, vn); } } }
    if constexpr (F32) {
#pragma unroll
        for (int d0 = 0; d0 < 8; ++d0) S.qr[d0] = pack8(S.tq[2 * d0], S.tq[2 * d0 + 1]); }
    __syncthreads();
#undef RESC
#undef KBASE
#undef ACT
#undef MASKT
#undef SEAM_K0
#undef HALF_STEP
}
#undef ROW
#undef VMW
#undef VMWN
#undef SLOAD_H
#undef SLOAD_B
#undef SWRITE_B
#undef SWRITE_HK
#undef SWRITE_HV
#undef SWRITE_H
#undef SLOAD_F
#undef SWRITE_KF
#undef SWRITE_VF

#undef KSWZ
#undef SBAR
}

#ifndef MK_N_LAUNCHES
#define MK_N_LAUNCHES 1
#endif
#define LAS __attribute__((address_space(3)))
typedef unsigned short bf16_t;
typedef float f32x4 __attribute__((ext_vector_type(4)));
typedef unsigned u32x4 __attribute__((ext_vector_type(4)));
typedef unsigned u32x2 __attribute__((ext_vector_type(2)));
typedef short bf16x8 __attribute__((ext_vector_type(8)));

constexpr int DM = 1024, NB = 8, SEQ = 4096, NMETA = 16, LB = SEQ + NMETA, NH = 8, HD = 128, DFF = 2816, DIN = 8200;
constexpr int MMAIN = NB * SEQ, NROWS = NB * LB;
constexpr int NPROJ = 8192;
constexpr int CP = 4224;
constexpr float RMS_EPS = 1e-6f;
constexpr int NPHASE = 10;
constexpr int NWAVES = 8, NTHREADS = 512;
constexpr int LDS_BYTES = 139264;
constexpr int LDS_HALO = 131072;
constexpr int LDS_SROW = 136192;
constexpr int LDS_MISC = 135168;
constexpr size_t WS_PCNT = 16384;
constexpr size_t WS_CTL = 0, WS_SS = 65536, CTL_ZERO_BYTES = 65536 + 196608;

constexpr size_t MiB = 1u << 20;
constexpr size_t WS_LOGF = 1 * MiB, WS_C = 3 * MiB, WS_Z1M = 5 * MiB, WS_WO = 6 * MiB, WS_WFI = 8 * MiB, WS_WDN = 19 * MiB;
constexpr size_t WS_SLOT0 = 26 * MiB, SLOT = 65 * MiB;
constexpr size_t WS_Q = WS_SLOT0, WS_K = WS_SLOT0 + SLOT, WS_V = WS_SLOT0 + 2 * SLOT, WS_GB = WS_SLOT0 + 3 * SLOT, WS_CU = WS_SLOT0 + 4 * SLOT, WS_GA = WS_SLOT0 + 5 * SLOT, WS_GC = WS_SLOT0 + 6 * SLOT;
constexpr size_t WS_T = WS_Q, WS_MX = WS_K;
constexpr size_t WS_AHEAD = WS_SLOT0, WS_VHEAD = WS_SLOT0 + 3 * MiB, WS_ATAIL = WS_SLOT0 + 6 * MiB, WS_AMETA = WS_SLOT0 + 9 * MiB;
constexpr size_t WS_XB = WS_SLOT0 + 12 * MiB;
constexpr size_t WS_A = WS_SLOT0, WS_VAL = WS_SLOT0 + 178 * MiB, WS_H2 = WS_SLOT0 + 356 * MiB;
constexpr size_t WS_END = WS_SLOT0 + 7 * SLOT;
static_assert(WS_H2 + SLOT <= WS_END && (size_t)NROWS * DFF * 2 <= 178 * MiB && (size_t)(NROWS + 64) * DM * 2 <= SLOT, "ws map");
constexpr size_t DO_XN = 0, DO_WIN = 66 * MiB, DO_WA = 82 * MiB, DO_WC = 84 * MiB;
constexpr size_t DO_CUHEAD = 100 * MiB, DO_GBHEAD = 101 * MiB, DO_CUTAIL = 102 * MiB;

__device__ __forceinline__ unsigned cvtpk(float lo, float hi) { return pg8::cvt_pk_bf16(lo, hi); }
__device__ __forceinline__ float bf2f(bf16_t x) { return __uint_as_float((unsigned)x << 16); }
__device__ __forceinline__ void unpk8(const u32x4 w, float (&f)[8]) {
#pragma unroll
    for (int i = 0; i < 4; ++i) { f[2 * i] = __uint_as_float(w[i] << 16); f[2 * i + 1] = __uint_as_float(w[i] & 0xffff0000u); }
}
__device__ __forceinline__ float wave_sum(float v) {
#pragma unroll
    for (int o = 1; o < 64; o <<= 1) v += __shfl_xor(v, o);
    return v;
}
#define LDS_WAIT() asm volatile("s_waitcnt lgkmcnt(0)" ::: "memory")

__device__ __forceinline__ int win_conv_src(int n) {
    const int t = (n - 3072) >> 8, w = (n - 3072) & 255, bj = w >> 7, wc = (w >> 5) & 3, fq = (w >> 3) & 3, slot = (w >> 2) & 1, c = 64 * t + 16 * wc + 4 * fq;
    return (bj == 0 ? (slot == 0 ? 3080 : 4104) : (slot == 0 ? 5128 : 7176)) + c;
}
__device__ __forceinline__ void p0_transpose_item(const float* W, int ldw, int k0, int srccol0, bf16_t* WT, int K, int dstrow0, LAS float* scr, int lane, const float* kscale = nullptr, bool convmode = false) {
#pragma unroll
    for (int i = 0; i < 8; ++i) { const int kk = 8 * i + (lane >> 3), n4 = (lane & 7) * 4; f32x4 w = *(const f32x4*)(W + (size_t)(k0 + kk) * ldw + (convmode ? win_conv_src(dstrow0 + n4) : srccol0 + n4)); if (kscale) w = w * kscale[k0 + kk];
        scr[kk * 33 + n4] = w.x; scr[kk * 33 + n4 + 1] = w.y; scr[kk * 33 + n4 + 2] = w.z; scr[kk * 33 + n4 + 3] = w.w; }
    LDS_WAIT(); asm volatile("" ::: "memory");
    const int c = lane & 7;
#pragma unroll
    for (int j = 0; j < 4; ++j) { const int n = (lane >> 3) + 8 * j; const LAS float* s = scr + (8 * c) * 33 + n;
        u32x4 o; o.x = cvtpk(s[0 * 33], s[1 * 33]); o.y = cvtpk(s[2 * 33], s[3 * 33]); o.z = cvtpk(s[4 * 33], s[5 * 33]); o.w = cvtpk(s[6 * 33], s[7 * 33]);
        *(u32x4*)(WT + (size_t)(dstrow0 + n) * K + k0 + 8 * c) = o; }
    LDS_WAIT(); asm volatile("" ::: "memory");
}
__device__ __forceinline__ int win_src(int n0) {
    if (n0 < 3072) return n0;
    if (n0 < 4096) return 3080 + (n0 - 3072);
    if (n0 < 6144) { const int j = (n0 - 4096) >> 8, w = (n0 - 4096) & 255; return w < 128 ? 4104 + 128 * j + w : 5128 + 128 * j + (w - 128); }
    return 6152 + (n0 - 6144);
}
__device__ __forceinline__ int wfi_src(int n0) { const int j = n0 >> 8, w = n0 & 255; return w < 128 ? 128 * j + w : DFF + 128 * j + (w - 128); }

__device__ __forceinline__ void norm_row(const float* src, const float* g, bf16_t* dst, int lane, f32x4 (&y)[4]) {
    float ss = 0.f;
#pragma unroll
    for (int j = 0; j < 4; ++j) { y[j] = ((const f32x4*)src)[64 * j + lane]; ss += (y[j].x * y[j].x + y[j].y * y[j].y) + (y[j].z * y[j].z + y[j].w * y[j].w); }
    ss = wave_sum(ss);
    const float rstd = 1.0f / sqrtf(ss * (1.0f / DM) + RMS_EPS);
#pragma unroll
    for (int j = 0; j < 4; ++j) { const f32x4 gg = ((const f32x4*)g)[64 * j + lane]; y[j] = (y[j] * rstd) * gg;
        u32x2 o; o.x = cvtpk(y[j].x, y[j].y); o.y = cvtpk(y[j].z, y[j].w); *(u32x2*)(dst + 256 * j + 4 * lane) = o; }
}
__device__ __forceinline__ f32x4 mini_tile(const bf16_t* A, int lda, const bf16_t* Bt, int K, int n0, int lane) {
    const int fr = lane & 15, fq = lane >> 4; f32x4 acc = {0.f, 0.f, 0.f, 0.f};
    const bf16x8* ap = (const bf16x8*)(A + (size_t)fr * lda + fq * 8); const bf16x8* bp = (const bf16x8*)(Bt + (size_t)(n0 + fr) * K + fq * 8);
#pragma unroll 16
    for (int k = 0; k < K / 32; ++k) acc = __builtin_amdgcn_mfma_f32_16x16x32_bf16(bp[k * 4], ap[k * 4], acc, 0, 0, 0);
    return acc;
}
__device__ __forceinline__ void store4_allb(bf16_t* base, int fr, int col, const f32x4 v) {
    u32x2 o; o.x = cvtpk(v[0], v[1]); o.y = cvtpk(v[2], v[3]);
#pragma unroll
    for (int b = 0; b < NB; ++b) *(u32x2*)(base + (size_t)(b * LB + fr) * DM + col) = o;
}
__device__ __forceinline__ float sigm(float x) { return __builtin_amdgcn_rcpf(1.0f + __expf(-x)); }

#define XB_TMO      128
#define XB_XCNT(j)  (256  + 64 * (j))
#define XB_XSUB(j)  (1280 + 64 * (j))
#define XB_XGEN(j)  (2304 + 64 * (j))
#define XB_TOP      3328
#define XB_TOPGEN   3392
#define XCD_BAR_WORDS 3456
#define XB_SPIN_CAP (1u << 18)

__device__ __forceinline__ unsigned xb_ld(unsigned* p)              { return __hip_atomic_load(p, __ATOMIC_RELAXED, __HIP_MEMORY_SCOPE_AGENT); }
__device__ __forceinline__ unsigned xb_add(unsigned* p, unsigned v) { return __hip_atomic_fetch_add(p, v, __ATOMIC_RELAXED, __HIP_MEMORY_SCOPE_AGENT); }
__device__ __forceinline__ unsigned xb_xcc_id() { return (unsigned)__builtin_amdgcn_s_getreg((3 << 11) | 20) & 0xFu; }
#define XB_SPIN(cond, bar) do { unsigned _sp = 0; while (cond) { __builtin_amdgcn_s_sleep(1); \
    if ((++_sp & 255u) == 0u) { if (xb_ld(&(bar)[XB_TMO])) break; if (_sp > XB_SPIN_CAP) { atomicAdd(&(bar)[XB_TMO], 1u); break; } } } } while (0)

struct XcdBarrier {
    unsigned* bar; unsigned x;
    volatile LAS unsigned* st;
};

__device__ __forceinline__ XcdBarrier xcd_barrier_post(unsigned* bar, volatile LAS unsigned* st) {
    XcdBarrier b; b.bar = bar; b.x = xb_xcc_id(); b.st = st;
    if (threadIdx.x == 0) (void)xb_add(&bar[XB_XCNT(b.x)], 1u);
    return b;
}
__device__ __forceinline__ void xcd_barrier_complete(unsigned* bar, unsigned x, unsigned& nloc, unsigned& nx) {
    const unsigned G = gridDim.x * gridDim.y * gridDim.z;
    unsigned sum, cnt, mine, sp = 0u;
    for (;;) {
        sum = 0u; cnt = 0u; mine = 0u;
#pragma unroll
        for (unsigned j = 0; j < 16; ++j) { const unsigned c = xb_ld(&bar[XB_XCNT(j)]); sum += c; cnt += (c > 0u) ? 1u : 0u; mine = (j == x) ? c : mine; }
        if (sum == G) break;
        __builtin_amdgcn_s_sleep(1);
        if ((++sp & 255u) == 0u) { if (xb_ld(&bar[XB_TMO])) break; if (sp > XB_SPIN_CAP) { atomicAdd(&bar[XB_TMO], 1u); break; } }
    }
    nloc = mine > 0u ? mine : 1u; nx = cnt > 0u ? cnt : 1u;
}

__device__ __forceinline__ void xcd_barrier(const XcdBarrier& b) {
    asm volatile("s_waitcnt vmcnt(0)" ::: "memory");
    __syncthreads();
    if (threadIdx.x == 0) {
        unsigned* bar = b.bar;
        __builtin_amdgcn_s_waitcnt(0);
        unsigned nloc = b.st[0], nx = b.st[1];
        if (nloc == 0u) { xcd_barrier_complete(bar, b.x, nloc, nx); b.st[0] = nloc; b.st[1] = nx; }
        const unsigned old = xb_add(&bar[XB_XSUB(b.x)], 1u);
        const unsigned gen = old / nloc;
        if (old + 1u == (gen + 1u) * nloc) {
            __builtin_amdgcn_fence(__ATOMIC_RELEASE, "agent");
            asm volatile("s_waitcnt vmcnt(0)" ::: "memory");
            const unsigned og = xb_add(&bar[XB_TOP], 1u);
            const unsigned tg = og / nx;
            if (og + 1u == (tg + 1u) * nx) xb_add(&bar[XB_TOPGEN], 1u);
            else XB_SPIN(xb_ld(&bar[XB_TOPGEN]) == tg, bar);
            __builtin_amdgcn_fence(__ATOMIC_ACQUIRE, "agent");
            xb_add(&bar[XB_XGEN(b.x)], 1u);
            asm volatile("s_waitcnt vmcnt(0)" ::: "memory");
        } else {
            XB_SPIN(xb_ld(&bar[XB_XGEN(b.x)]) == gen, bar);
            __builtin_amdgcn_fence(__ATOMIC_ACQUIRE, "agent");
            asm volatile("s_waitcnt vmcnt(0)" ::: "memory");
        }
    }
    __syncthreads();
}

__device__ __forceinline__ att::BlockRef<att::bf16, att::bf16> att_ref(int it, int second, int nitems, const bf16_t* Qb, const bf16_t* Kb, const bf16_t* Vb, bf16_t* Ob, const float* CC) {
    if (it >= nitems) it = nitems - 1;
    const int bh = it >> 3, xx = it & 7, b = bh >> 3, h = bh & 7, qb = second ? 15 - xx : xx;
    att::BlockRef<att::bf16, att::bf16> r; const size_t rb = (size_t)b * LB;
    r.Q = (const att::bf16*)Qb + (rb + NMETA + (size_t)qb * 256) * DM + h * HD; r.O = (att::bf16*)Ob + (rb + NMETA + (size_t)qb * 256) * DM + h * HD;
    r.K = (const att::bf16*)Kb + rb * DM + h * HD; r.V = (const att::bf16*)Vb + rb * DM + h * HD; r.C = CC + (size_t)bh * CP; r.P0 = NMETA + qb * 256; return r;
}
struct Args { const float* in[14]; float* out; unsigned char* ws; int ph_lo, ph_hi; };

#define LOAD_PTRS() \
    const __attribute__((address_space(4))) Args* ap_ = (const __attribute__((address_space(4))) Args*)__builtin_amdgcn_kernarg_segment_ptr(); asm volatile("" : "+s"(ap_)); \
    int tid_ = (int)threadIdx.x; asm volatile("" : "+v"(tid_)); const int tid = tid_, lane = tid_ & 63; (void)tid; (void)lane; \
    const float* x = ap_->in[0]; const float* meta = ap_->in[1]; const float* g_mix = ap_->in[2]; const float* w_in = ap_->in[3]; const float* b_f = ap_->in[4]; \
    const float* conv_w = ap_->in[5]; const float* w_o_attn = ap_->in[6]; const float* w_o_conv = ap_->in[7]; const float* w_o = ap_->in[8]; const float* g_ffn = ap_->in[9]; \
    const float* w_ffn_in = ap_->in[10]; const float* ffn_conv_w = ap_->in[11]; const float* w_ffn_out = ap_->in[12]; const float* g_final = ap_->in[13]; \
    unsigned char* ws = ap_->ws; unsigned char* dob = (unsigned char*)ap_->out; float* out = ap_->out; \
    float* SS = (float*)(ws + WS_SS); float* AHEAD = (float*)(ws + WS_AHEAD); float* VHEAD = (float*)(ws + WS_VHEAD); float* ATAIL = (float*)(ws + WS_ATAIL); float* AMETA = (float*)(ws + WS_AMETA); float* LOGF = (float*)(ws + WS_LOGF); float* CC = (float*)(ws + WS_C); float* Z1M = (float*)(ws + WS_Z1M); \
    bf16_t* Wo_t = (bf16_t*)(ws + WS_WO); bf16_t* Wfi_t = (bf16_t*)(ws + WS_WFI); bf16_t* Wdn_t = (bf16_t*)(ws + WS_WDN); \
    bf16_t* Qb = (bf16_t*)(ws + WS_Q); bf16_t* Kb = (bf16_t*)(ws + WS_K); bf16_t* Vb = (bf16_t*)(ws + WS_V); bf16_t* GBb = (bf16_t*)(ws + WS_GB); bf16_t* CUb = (bf16_t*)(ws + WS_CU); \
    bf16_t* GAb = (bf16_t*)(ws + WS_GA); bf16_t* GCb = (bf16_t*)(ws + WS_GC); bf16_t* Tb = (bf16_t*)(ws + WS_T); bf16_t* MXb = (bf16_t*)(ws + WS_MX); \
    bf16_t* FAb = (bf16_t*)(ws + WS_A); bf16_t* FVb = (bf16_t*)(ws + WS_VAL); bf16_t* H2b = (bf16_t*)(ws + WS_H2); \
    bf16_t* XNb = (bf16_t*)(dob + DO_XN); bf16_t* Win_t = (bf16_t*)(dob + DO_WIN); bf16_t* Wa_t = (bf16_t*)(dob + DO_WA); bf16_t* Wc_t = (bf16_t*)(dob + DO_WC); \
    float* CUHEAD = (float*)(dob + DO_CUHEAD); float* GBHEAD = (float*)(dob + DO_GBHEAD); float* CUTAIL = (float*)(dob + DO_CUTAIL); bf16_t* Ob = XNb;
__global__ void __launch_bounds__(NTHREADS, 2) fwd_kernel(Args args) {
    extern __shared__ __attribute__((aligned(16))) unsigned char lds[];
    const int tid = threadIdx.x, lane = tid & 63, wave = __builtin_amdgcn_readfirstlane(tid >> 6);
    const int G = gridDim.x, bx = blockIdx.x;
    const int vcu = (G % 8 == 0) ? (bx % 8) * (G / 8) + bx / 8 : bx;
    const int gw = bx * NWAVES + wave, NGW = G * NWAVES;
    const int gwT = wave * G + bx;
    LAS unsigned char* glds = (LAS unsigned char*)lds;
    if (args.ph_lo < -5) cg::this_grid().sync();
    if (tid < 2) ((volatile LAS unsigned*)(lds + LDS_MISC))[tid] = 0u;
    __syncthreads();
    if (args.ph_hi - args.ph_lo > 1) (void)xcd_barrier_post((unsigned*)(args.ws + WS_CTL), (volatile LAS unsigned*)(lds + LDS_MISC));
    const int lo = args.ph_lo, hi = args.ph_hi;
#ifdef ONLY_PHASE
#define IN(k) ((k) == ONLY_PHASE && lo <= (k) && (k) < hi)
#else
#define IN(k) (lo <= (k) && (k) < hi)
#endif
#define SEAM(k) do { if (IN(k) && IN((k) + 1)) { XcdBarrier b_; b_.bar = (unsigned*)(((const __attribute__((address_space(4))) Args*)__builtin_amdgcn_kernarg_segment_ptr())->ws + WS_CTL); b_.x = xb_xcc_id(); b_.st = (volatile LAS unsigned*)(lds + LDS_MISC); xcd_barrier(b_); } } while (0)

    if (IN(0)) { LOAD_PTRS();
        LAS float* wfT = (LAS float*)(lds + 69632);
        for (int k = tid; k < DM; k += NTHREADS) { const f32x4 a = *(const f32x4*)(w_in + (size_t)k * DIN + 3072), b = *(const f32x4*)(w_in + (size_t)k * DIN + 3076);
            wfT[0 * DM + k] = a.x; wfT[1 * DM + k] = a.y; wfT[2 * DM + k] = a.z; wfT[3 * DM + k] = a.w; wfT[4 * DM + k] = b.x; wfT[5 * DM + k] = b.y; wfT[6 * DM + k] = b.z; wfT[7 * DM + k] = b.w; }
        __syncthreads();
        f32x4 nx[4];
        { const int r = gw; if (r < NROWS) { const int b = r / LB, pos = r - b * LB; const float* src = pos < NMETA ? meta + (size_t)pos * DM : x + ((size_t)b * SEQ + (pos - NMETA)) * DM;
#pragma unroll
            for (int j = 0; j < 4; ++j) nx[j] = ((const f32x4*)src)[64 * j + lane]; } }
        for (int r = gw; r < NROWS; r += NGW) {
            const int b = r / LB, pos = r - b * LB;
            f32x4 y[4];
#pragma unroll
            for (int j = 0; j < 4; ++j) y[j] = nx[j];
            { const int rn = r + NGW; if (rn < NROWS) { const int bn = rn / LB, posn = rn - bn * LB; const float* src = posn < NMETA ? meta + (size_t)posn * DM : x + ((size_t)bn * SEQ + (posn - NMETA)) * DM;
#pragma unroll
                for (int j = 0; j < 4; ++j) nx[j] = ((const f32x4*)src)[64 * j + lane]; } }
            float ss = 0.f;
#pragma unroll
            for (int j = 0; j < 4; ++j) ss += (y[j].x * y[j].x + y[j].y * y[j].y) + (y[j].z * y[j].z + y[j].w * y[j].w);
            ss = wave_sum(ss);
            const float rstd = 1.0f / sqrtf(ss * (1.0f / DM) + RMS_EPS);
            bf16_t* dst = XNb + (size_t)r * DM;
#pragma unroll
            for (int j = 0; j < 4; ++j) { const f32x4 gg = ((const f32x4*)g_mix)[64 * j + lane]; y[j] = (y[j] * rstd) * gg;
                u32x2 o; o.x = cvtpk(y[j].x, y[j].y); o.y = cvtpk(y[j].z, y[j].w); *(u32x2*)(dst + 256 * j + 4 * lane) = o; }
            float f[8];
#pragma unroll
            for (int h = 0; h < 8; ++h) { float s = 0.f;
#pragma unroll
                for (int j = 0; j < 4; ++j) { const f32x4 w = *(const LAS f32x4*)(wfT + h * DM + 256 * j + 4 * lane); s += (y[j].x * w.x + y[j].y * w.y) + (y[j].z * w.z + y[j].w * w.w); }
                f[h] = s; }
            const bool b5 = lane & 32, b4 = lane & 16, b3 = lane & 8;
            float f4[4], f2[2];
#pragma unroll
            for (int h = 0; h < 4; ++h) { const float keep = b5 ? f[h + 4] : f[h], send = b5 ? f[h] : f[h + 4]; f4[h] = keep + __shfl_xor(send, 32); }
#pragma unroll
            for (int h = 0; h < 2; ++h) { const float keep = b4 ? f4[h + 2] : f4[h], send = b4 ? f4[h] : f4[h + 2]; f2[h] = keep + __shfl_xor(send, 16); }
            float fv; { const float keep = b3 ? f2[1] : f2[0], send = b3 ? f2[0] : f2[1]; fv = keep + __shfl_xor(send, 8); }
            fv += __shfl_xor(fv, 4); fv += __shfl_xor(fv, 2); fv += __shfl_xor(fv, 1);
            if ((lane & 7) == 0) { const int h = lane >> 3; const float z = fv + b_f[h]; const float lf = fminf(z, 0.f) - log1pf(expf(-fabsf(z))); LOGF[(size_t)(b * NH + h) * CP + pos] = lf; }
        }
        LAS float* scr = (LAS float*)(lds + wave * 8448);
        constexpr int I_IN = 16 * 256, I_SQ = 16 * 32, I_FI = 16 * 176, I_DN = 44 * 32, NITEMS = I_IN + 3 * I_SQ + I_FI + I_DN;
        for (int it = gw; it < NITEMS; it += NGW) {
            int r = it;
            if (r < I_IN) { const int kb = r >> 8, nb = r & 255, n0 = 32 * nb; const bool cv = n0 >= 3072 && n0 < 7168;
                p0_transpose_item(w_in, DIN, 64 * kb, n0 < 3072 ? n0 : 6152 + (n0 - 7168), Win_t, DM, n0, scr, lane, nullptr, cv); continue; } r -= I_IN;
            if (r < I_SQ) { p0_transpose_item(w_o_attn, DM, 64 * (r >> 5), 32 * (r & 31), Wa_t, DM, 32 * (r & 31), scr, lane); continue; } r -= I_SQ;
            if (r < I_SQ) { p0_transpose_item(w_o_conv, DM, 64 * (r >> 5), 32 * (r & 31), Wc_t, DM, 32 * (r & 31), scr, lane); continue; } r -= I_SQ;
            if (r < I_SQ) { p0_transpose_item(w_o, DM, 64 * (r >> 5), 32 * (r & 31), Wo_t, DM, 32 * (r & 31), scr, lane); continue; } r -= I_SQ;
            if (r < I_FI) { const int kb = r / 176, nb = r % 176; p0_transpose_item(w_ffn_in, 2 * DFF, 64 * kb, wfi_src(32 * nb), Wfi_t, DM, 32 * nb, scr, lane, g_ffn); continue; }     r -= I_FI;
            p0_transpose_item(w_ffn_out, DM, 64 * (r >> 5), 32 * (r & 31), Wdn_t, DFF, 32 * (r & 31), scr, lane);
        }
        __syncthreads();
    }
    SEAM(0);

    if (IN(1)) { LOAD_PTRS();
        if (gwT < NB * NH) {
            const float* src = LOGF + (size_t)gwT * CP; float* dst = CC + (size_t)gwT * CP;
            float vals[66];
#pragma unroll
            for (int i = 0; i < 66; ++i) { const int pos = 64 * i + lane; vals[i] = pos < LB ? src[pos] : 0.f; }
            double carry = 0.0;
#pragma unroll
            for (int i = 0; i < 66; ++i) { float v = vals[i];
#pragma unroll
                for (int o = 1; o < 64; o <<= 1) { const float t = __shfl_up(v, o); if (lane >= o) v += t; }
                dst[64 * i + lane] = (float)(-(carry + (double)v) * (double)att::INV_SCALE);     carry += (double)__shfl(v, 63); }
        }
        for (int j = gwT; j < NPROJ / 16; j += NGW) {
            const int n0 = 16 * j, fr = lane & 15, fq = lane >> 4;
            if (n0 < 3072) { const f32x4 v = mini_tile(XNb, DM, Win_t, DM, n0, lane); store4_allb(n0 < 1024 ? Qb : n0 < 2048 ? Kb : Vb, fr, (n0 & 1023) + 4 * fq, v); }
            else if (n0 < 7168) {
                const int t = (n0 - 3072) >> 8, w0 = (n0 - 3072) & 255;
                if (w0 < 128) { const f32x4 a = mini_tile(XNb, DM, Win_t, DM, n0, lane), b = mini_tile(XNb, DM, Win_t, DM, n0 + 128, lane);
                    const int ch = 64 * t + 16 * ((w0 >> 5) & 3) + 4 * (((w0 >> 3) & 3) + (fq >> 1)); f32x4 ub;
#pragma unroll
                    for (int e = 0; e < 4; ++e) ub[e] = __shfl(b[e], lane - 16);
                    const f32x4 cu = a * ub, w0 = *(const f32x4*)(conv_w + ch), w1 = *(const f32x4*)(conv_w + DM + ch), w2 = *(const f32x4*)(conv_w + 2 * DM + ch); f32x4 cv, cvs;
#pragma unroll
                    for (int e = 0; e < 4; ++e) { cv[e] = w0[e] * pg8::dpp_shr2(0.f, cu[e]) + w1[e] * pg8::dpp_shr1(0.f, cu[e]) + w2[e] * cu[e]; cvs[e] = __shfl(cv[e], lane + 16); }
                    if (fq & 1) { f32x4 gcv;
#pragma unroll
                        for (int e = 0; e < 4; ++e) gcv[e] = sigm(b[e]);
                        store4_allb(CUb, fr, ch, cu); store4_allb(GCb, fr, ch, gcv); }
                    else store4_allb(GBb, fr, ch, a * cvs); } }
            else { f32x4 v = mini_tile(XNb, DM, Win_t, DM, n0, lane);
#pragma unroll
                for (int e = 0; e < 4; ++e) v[e] = sigm(v[e]);
                store4_allb(GAb, fr, (n0 - 7168) + 4 * fq, v); }
        }
        pg8::Gemm g{XNb, Win_t, MMAIN, NPROJ, DM}; pg8::StaticOrder S; S.init(MMAIN, NPROJ, G, bx);
        pg8::EpiProj E{Qb, (size_t)(SLOT / 2), GBb, GAb, GCb, conv_w, CUHEAD, GBHEAD, CUTAIL, (LAS float*)(lds + LDS_HALO)};
        pg8::gemm_phase<pg8::EpiProj, pg8::StaticOrder, true, true>(glds, g, S, E);
    }
    SEAM(1);

    if (IN(2)) { LOAD_PTRS();
        {
            typedef att::BlockRef<att::bf16, att::bf16> BR;
            const int nitems = NB * NH * 8, per = (nitems + G - 1) / G;
            att::Seam<att::bf16> S;
#define mk(k) att_ref(vcu * per + ((k) >> 1), (k) & 1, nitems, Qb, Kb, Vb, Ob, CC)
            int nblk = 2 * per; { const int first = vcu * per; if (first >= nitems) nblk = 0; else if (first + per > nitems) nblk = 2 * (nitems - first); }
#ifndef NO_ATT
            if (nblk > 0) {
                BR cur = mk(0);
                att::causal_swa_prime<att::bf16, att::bf16>(cur, 1 << 24, (char*)lds, S);
                for (int k = 0; k < nblk; ++k) { const BR nxt = (k + 1 < nblk) ? mk(k + 1) : cur;
                    att::causal_swa_block<att::bf16, att::bf16>(cur, nxt, 4160, 1 << 24, (char*)lds, S); cur = nxt; }
            }
#endif
#undef mk
            __syncthreads();
        }
        for (int job = gwT; job < NH * NMETA; job += NGW) {
            const int h = job >> 4, i = job & 15, jk = lane & 15, part = lane >> 4; const float* c = CC + (size_t)h * CP;
            float dsum = 0.f;
            { const bf16_t* qp = Qb + (size_t)i * DM + h * HD + part * 32; const bf16_t* kp = Kb + (size_t)jk * DM + h * HD + part * 32;
#pragma unroll
              for (int d8 = 0; d8 < 4; ++d8) { float tq[8], tk[8]; unpk8(*(const u32x4*)(qp + 8 * d8), tq); unpk8(*(const u32x4*)(kp + 8 * d8), tk);
#pragma unroll
                  for (int e = 0; e < 8; ++e) dsum += tq[e] * tk[e]; } }
            dsum += __shfl_xor(dsum, 16); dsum += __shfl_xor(dsum, 32);
            const bool ok = jk <= i; const float sj = ok ? (dsum + (c[jk] - c[i])) * att::SCALE : -1e30f;
            float mx = sj;
#pragma unroll
            for (int o = 1; o < 16; o <<= 1) mx = fmaxf(mx, __shfl_xor(mx, o));
            float p = ok ? __expf(sj - mx) : 0.f, l = p;
#pragma unroll
            for (int o = 1; o < 16; o <<= 1) l += __shfl_xor(l, o);
            p *= 1.0f / l;
            float o0 = 0.f, o1 = 0.f;
#pragma unroll
            for (int jj = 0; jj < 16; ++jj) { const float pj = __shfl(p, jj); const unsigned vv = *(const unsigned*)(Vb + (size_t)jj * DM + h * HD + 2 * lane);
                o0 += pj * __uint_as_float(vv << 16); o1 += pj * __uint_as_float(vv & 0xffff0000u); }
            *(unsigned*)(Ob + (size_t)i * DM + h * HD + 2 * lane) = cvtpk(o0, o1);
        }
    }
    SEAM(2);

    if (IN(3)) { LOAD_PTRS();
        for (int j = gwT; j < DM / 16; j += NGW) {
            const int n0 = 16 * j, fr = lane & 15, fq = lane >> 4, col = n0 + 4 * fq;
            const f32x4 ya = mini_tile(Ob, DM, Wa_t, DM, n0, lane), yc = mini_tile(GBb, DM, Wc_t, DM, n0, lane);
            const u32x2 ga = *(const u32x2*)(GAb + (size_t)fr * DM + col), gc = *(const u32x2*)(GCb + (size_t)fr * DM + col);
            f32x4 m;
            m[0] = __uint_as_float(ga.x << 16) * ya[0] + __uint_as_float(gc.x << 16) * yc[0]; m[1] = __uint_as_float(ga.x & 0xffff0000u) * ya[1] + __uint_as_float(gc.x & 0xffff0000u) * yc[1];
            m[2] = __uint_as_float(ga.y << 16) * ya[2] + __uint_as_float(gc.y << 16) * yc[2]; m[3] = __uint_as_float(ga.y & 0xffff0000u) * ya[3] + __uint_as_float(gc.y & 0xffff0000u) * yc[3];
            u32x2 o; o.x = cvtpk(m[0], m[1]); o.y = cvtpk(m[2], m[3]); *(u32x2*)(MXb + (size_t)fr * DM + col) = o;
        }
        {
            pg8::StaticOrder S0; S0.init(MMAIN, DM, G, bx); pg8::Unit uu;
            for (int i = 0; S0.next(i, uu); ++i) { const int pm = uu.pm;
                for (int c = tid; c < DM; c += NTHREADS) { float cm2, cm1;
                    if (pm & 15) { cm2 = CUTAIL[(size_t)(pm - 1) * 2 * DM + c]; cm1 = CUTAIL[((size_t)(pm - 1) * 2 + 1) * DM + c]; }
                    else { const size_t mr = (size_t)(pm >> 4) * LB; cm2 = bf2f(CUb[(mr + 14) * DM + c]); cm1 = bf2f(CUb[(mr + 15) * DM + c]); }
                    const float c0 = CUHEAD[(size_t)pm * 2 * DM + c], c1 = CUHEAD[((size_t)pm * 2 + 1) * DM + c], w0 = conv_w[c], w1 = conv_w[DM + c], w2 = conv_w[2 * DM + c];
                    const float y0 = GBHEAD[(size_t)pm * 2 * DM + c] * (w0 * cm2 + w1 * cm1 + w2 * c0), y1 = GBHEAD[((size_t)pm * 2 + 1) * DM + c] * (w0 * cm1 + w1 * c0 + w2 * c1);
                    bf16_t* yp = GBb + (size_t)pg8::arow(pm) * DM + c; yp[0] = (bf16_t)(cvtpk(y0, 0.f) & 0xffffu); yp[DM] = (bf16_t)(cvtpk(y1, 0.f) & 0xffffu); } }
            asm volatile("s_waitcnt vmcnt(0)" ::: "memory"); __syncthreads();
        }
        { pg8::Gemm g{Ob, Wa_t, MMAIN, DM, DM}; g.nt2 = DM / 64; g.dA = (long)((const char*)GBb - (const char*)Ob); g.dB = (long)((const char*)Wc_t - (const char*)Wa_t);
          pg8::StaticOrder S; S.init(MMAIN, DM, G, bx); pg8::EpiGate2 E{GAb, GCb, MXb};
          pg8::gemm_phase<pg8::EpiGate2, pg8::StaticOrder, true, true>(glds, g, S, E); }
    }
    SEAM(3);

    if (IN(4)) { LOAD_PTRS();
        for (int j = gwT; j < DM / 16; j += NGW) {
            const int n0 = 16 * j, fr = lane & 15, fq = lane >> 4, col = n0 + 4 * fq;
            const f32x4 v = *(const f32x4*)(meta + (size_t)fr * DM + col) + mini_tile(MXb, DM, Wo_t, DM, n0, lane);
            u32x2 o; o.x = cvtpk(v[0], v[1]); o.y = cvtpk(v[2], v[3]); *(u32x2*)(H2b + (size_t)fr * DM + col) = o;
            float s = (v[0] * v[0] + v[1] * v[1]) + (v[2] * v[2] + v[3] * v[3]); s += __shfl_xor(s, 16); s += __shfl_xor(s, 32);
            if (fq == 0) atomicAdd(SS + MMAIN + fr, s);
        }
        pg8::Gemm g{MXb, Wo_t, MMAIN, DM, DM}; pg8::StaticOrder S; S.init(MMAIN, DM, G, bx); pg8::EpiResSS E{x, out, H2b, SS};
        pg8::gemm_phase<pg8::EpiResSS, pg8::StaticOrder, true, true>(glds, g, S, E);
    }
    SEAM(4);


    if (IN(6)) { LOAD_PTRS();
        for (int j = gwT; j < DFF / 16; j += NGW) {
            const int c0 = 16 * j, fr = lane & 15, fq = lane >> 4;
            const float rs = 1.0f / sqrtf(SS[MMAIN + fr] * (1.0f / DM) + RMS_EPS);
            const f32x4 v = mini_tile(H2b, DM, Wfi_t, DM, 256 * (c0 >> 7) + (c0 & 127), lane) * rs;
            *(f32x4*)(AMETA + (size_t)fr * DFF + c0 + 4 * fq) = v;
        }
        pg8::Gemm g{H2b, Wfi_t, MMAIN, 2 * DFF, DM}; pg8::StaticOrder S; S.init(MMAIN, 2 * DFF, G, bx); pg8::EpiFfnConv E{FVb, SS, ffn_conv_w, AHEAD, VHEAD, ATAIL, (LAS float*)(lds + LDS_HALO)};
        pg8::gemm_phase<pg8::EpiFfnConv, pg8::StaticOrder, true, true>(glds, g, S, E);
    }
    SEAM(6);


    if (IN(8)) { LOAD_PTRS();
        pg8::Gemm g{FVb, Wdn_t, MMAIN, DM, DFF}; pg8::StaticOrder S; S.init(MMAIN, DM, G, bx); pg8::EpiResNorm E{H2b, out, g_final, (float*)(ws + WS_XB), (unsigned*)(ws + WS_PCNT), (LAS float*)(lds + LDS_HALO), (LAS float*)(lds + LDS_SROW)};
        {
            pg8::Unit uu;
            for (int i = 0; S.next(i, uu); ++i) { const int pm = uu.pm; const float* pa = (pm & 15) ? ATAIL + (size_t)(pm - 1) * 2 * DFF : AMETA + (size_t)14 * DFF;
                for (int c = tid; c < DFF; c += NTHREADS) { const float am2 = pa[c], am1 = pa[DFF + c], a0 = AHEAD[(size_t)pm * 2 * DFF + c], a1 = AHEAD[((size_t)pm * 2 + 1) * DFF + c];
                    const float w0 = ffn_conv_w[c], w1 = ffn_conv_w[DFF + c], w2 = ffn_conv_w[2 * DFF + c];
                    const float c0 = w0 * am2 + w1 * am1 + w2 * a0, c1 = w0 * am1 + w1 * a0 + w2 * a1;
                    const float s0 = c0 * sigm(c0) * VHEAD[(size_t)pm * 2 * DFF + c], s1 = c1 * sigm(c1) * VHEAD[((size_t)pm * 2 + 1) * DFF + c];
                    bf16_t* sp = FVb + (size_t)pg8::arow(pm) * DFF + c; sp[0] = (bf16_t)(cvtpk(s0, 0.f) & 0xffffu); sp[DFF] = (bf16_t)(cvtpk(s1, 0.f) & 0xffffu); } }
            asm volatile("s_waitcnt vmcnt(0)" ::: "memory"); __syncthreads();
        }
        pg8::gemm_phase<pg8::EpiResNorm, pg8::StaticOrder, true, true>(glds, g, S, E);
    }


#ifdef DUMP_AFTER
    if (lo == 100) { LOAD_PTRS();
        for (size_t i = (size_t)bx * NTHREADS + tid; i < (size_t)MMAIN * DM; i += (size_t)G * NTHREADS) {
            const int r = (int)(i >> 10), c = (int)(i & 1023); const size_t sr = (size_t)(r >> 12) * LB + NMETA + (r & 4095); const size_t mr = (size_t)((r >> 4) & 7) * LB + (r & 15);
            float v = 0.f;
#if DUMP_AFTER == 0
            v = bf2f(XNb[sr * DM + c]) + 3.f * bf2f(XNb[mr * DM + c]) + bf2f(Win_t[((size_t)r % 8192) * DM + c]) + bf2f(Wa_t[((size_t)r & 1023) * DM + c]) + bf2f(Wc_t[((size_t)r & 1023) * DM + c]) + bf2f(Wo_t[((size_t)r & 1023) * DM + c]) + bf2f(Wfi_t[((size_t)r % 5632) * DM + c]) + bf2f(Wdn_t[((size_t)(r & 1023)) * DFF + c]) + bf2f(Wdn_t[((size_t)(r & 1023)) * DFF + 1792 + c]) + LOGF[(size_t)(r & 63) * CP + (c + 1024 * ((r >> 6) & 3)) % LB];
#elif DUMP_AFTER == 1
            v = bf2f(Qb[sr * DM + c]) + 2.f * bf2f(Kb[sr * DM + c]) + 3.f * bf2f(Vb[sr * DM + c]) + 5.f * bf2f(GBb[sr * DM + c]) + 7.f * bf2f(CUb[sr * DM + c]) + 11.f * bf2f(GAb[sr * DM + c]) + 13.f * bf2f(GCb[sr * DM + c])
              + bf2f(Qb[mr * DM + c]) + 2.f * bf2f(Kb[mr * DM + c]) + 3.f * bf2f(Vb[mr * DM + c]) + 5.f * bf2f(GBb[mr * DM + c]) + 7.f * bf2f(CUb[mr * DM + c]) + 11.f * bf2f(GAb[mr * DM + c]) + 13.f * bf2f(GCb[mr * DM + c]) + 1e-3f * CC[(size_t)(r & 63) * CP + (c + 1024 * ((r >> 6) & 3))];
#elif DUMP_AFTER == 11
            v = 11.f * bf2f(GAb[sr * DM + c]) + 13.f * bf2f(GCb[sr * DM + c]);
#elif DUMP_AFTER == 12
            v = bf2f(Qb[sr * DM + c]) + 2.f * bf2f(Kb[sr * DM + c]) + 3.f * bf2f(Vb[sr * DM + c]) + 5.f * bf2f(GBb[sr * DM + c]) + 7.f * bf2f(CUb[sr * DM + c]);
#elif DUMP_AFTER == 13
            v = bf2f(Qb[mr * DM + c]) + 2.f * bf2f(Kb[mr * DM + c]) + 3.f * bf2f(Vb[mr * DM + c]) + 5.f * bf2f(GBb[mr * DM + c]) + 7.f * bf2f(CUb[mr * DM + c]) + 11.f * bf2f(GAb[mr * DM + c]) + 13.f * bf2f(GCb[mr * DM + c]);
#elif DUMP_AFTER == 14
            v = CC[(size_t)(r & 63) * CP + (c + 1024 * ((r >> 6) & 3))];
#elif DUMP_AFTER == 2
            v = bf2f(Ob[sr * DM + c]) + 3.f * bf2f(GBb[sr * DM + c]) + bf2f(Ob[(size_t)(r & 15) * DM + c]) + bf2f(GBb[mr * DM + c]);
#elif DUMP_AFTER == 3
            v = bf2f(MXb[sr * DM + c]) + bf2f(MXb[(size_t)(r & 15) * DM + c]);
#elif DUMP_AFTER == 5
            v = bf2f(H2b[sr * DM + c]) + bf2f(H2b[(size_t)(r & 15) * DM + c]);
#elif DUMP_AFTER == 6
            v = bf2f(FAb[sr * DFF + c]) + bf2f(FAb[sr * DFF + 1792 + c]) + 3.f * bf2f(FVb[sr * DFF + c]) + 3.f * bf2f(FVb[sr * DFF + 1792 + c]) + bf2f(FAb[mr * DFF + c]) + bf2f(FAb[mr * DFF + 1792 + c]);
#elif DUMP_AFTER == 7
            v = bf2f(FVb[sr * DFF + c]) + bf2f(FVb[sr * DFF + 1792 + c]);
#endif
#if DUMP_AFTER == 0 || DUMP_AFTER == 2
            ((float*)(ws + WS_Q))[i] = v; }
#else
            out[i] = v; }
#endif
    }
    if (lo == 101) { LOAD_PTRS(); for (size_t i = (size_t)bx * NTHREADS + tid; i < (size_t)MMAIN * DM; i += (size_t)G * NTHREADS) out[i] = ((const float*)(ws + WS_Q))[i]; }
#endif
#undef IN
#undef SEAM
}

extern "C" void kernel_launch(void* const* d_in, const int* in_sizes, int n_in, void* d_out, int out_size, void* d_ws, size_t ws_size, hipStream_t stream) {
    static int grid = 0;
    if (grid == 0) {
        if (n_in != 14 || in_sizes[0] != MMAIN * DM || out_size != MMAIN * DM || ws_size < WS_END) {
            fprintf(stderr, "kernel_launch: unexpected shapes (n_in %d, in0 %d, out %d, ws %zu; need ws >= %zu)\n", n_in, n_in > 0 ? in_sizes[0] : -1, out_size, ws_size, (size_t)WS_END); grid = -1; return; }
        int dev = 0, cus = 0, per_cu = 0;
        (void)hipGetDevice(&dev); (void)hipDeviceGetAttribute(&cus, hipDeviceAttributeMultiprocessorCount, dev);
        if (hipFuncSetAttribute((const void*)fwd_kernel, hipFuncAttributeMaxDynamicSharedMemorySize, LDS_BYTES) != hipSuccess) { fprintf(stderr, "kernel_launch: hipFuncSetAttribute failed\n"); grid = -1; return; }
        if (hipOccupancyMaxActiveBlocksPerMultiprocessor(&per_cu, (const void*)fwd_kernel, NTHREADS, LDS_BYTES) != hipSuccess || per_cu < 1) { fprintf(stderr, "kernel_launch: occupancy query says %d blocks per CU\n", per_cu); per_cu = 1; (void)hipGetLastError(); }
        if (cus <= 0) cus = 256;
        grid = cus;
    }
    if (grid < 0) return;
    if (hipMemsetAsync((char*)d_ws + WS_CTL, 0, CTL_ZERO_BYTES, stream) != hipSuccess) { fprintf(stderr, "kernel_launch: hipMemsetAsync failed\n"); return; }
    Args a{};
    for (int i = 0; i < 14; ++i) a.in[i] = (const float*)d_in[i];
    a.out = (float*)d_out; a.ws = (unsigned char*)d_ws;
#if MK_N_LAUNCHES == 1
    a.ph_lo = 0; a.ph_hi = NPHASE;
    void* kargs[] = {&a};
    hipError_t e = hipLaunchCooperativeKernel((const void*)fwd_kernel, dim3(grid), dim3(NTHREADS), kargs, LDS_BYTES, stream);
    if (e != hipSuccess) fprintf(stderr, "kernel_launch: cooperative launch failed: %s (grid %d)\n", hipGetErrorString(e), grid);
#else
#ifdef DUMP_AFTER
    const int np_ = (DUMP_AFTER >= 11 ? 1 : DUMP_AFTER) + 1;
#else
    const int np_ = NPHASE;
#endif
    for (int p = 0; p <= np_; ++p) { if (p == np_) {
#if defined(DUMP_AFTER) && DUMP_AFTER != 4 && DUMP_AFTER != 8
            a.ph_lo = 100; a.ph_hi = 101;
#if DUMP_AFTER == 0 || DUMP_AFTER == 2
            hipLaunchKernelGGL(fwd_kernel, dim3(grid), dim3(NTHREADS), LDS_BYTES, stream, a); a.ph_lo = 101; a.ph_hi = 102;
#endif
#else
            break;
#endif
        } else { a.ph_lo = p; a.ph_hi = p + 1; }
        hipLaunchKernelGGL(fwd_kernel, dim3(grid), dim3(NTHREADS), LDS_BYTES, stream, a);
        if (hipPeekAtLastError() != hipSuccess) { fprintf(stderr, "kernel_launch: launch %d failed\n", p); break; } }
#endif
}
```
